# Optimizing an MI355X kernel written in HIP

```python
import jax, jax.numpy as jnp
from jax import lax
import numpy as np

D_MODEL = 1024
BATCH = 4
SEQ = 4096
DEPTH = 2

N_MEM = 256
EPS = 1e-6
SC_WIDTH = D_MODEL // 2
SC_GROUPS = 8
CONV_K = 3
POOL_WIDTH = D_MODEL // 2
POOL_WINDOWS = (2, 4, 8, 16)
POOL_GROUP = POOL_WIDTH // len(POOL_WINDOWS)
EVEN_IN = 3 * SC_WIDTH + POOL_WIDTH
EVEN_MIX = SC_WIDTH + POOL_WIDTH
ML_HEADS = 4
ML_HEAD_DIM = 128
ML_WIDTH = ML_HEADS * ML_HEAD_DIM
ML_CHUNK = 64
MLA_HEADS = 8
QK_NOPE = 64
QK_ROPE = 32
V_DIM = 64
Q_LORA = 384
KV_LORA = 256
MLA_WIDTH = MLA_HEADS * V_DIM
Q_BLOCK = 128
ROPE_THETA = 10000.0
ODD_SIZES = (ML_WIDTH, ML_WIDTH, ML_WIDTH, ML_WIDTH, 2 * ML_HEADS, Q_LORA, KV_LORA, QK_ROPE)
ODD_SPLIT = tuple(int(v) for v in np.cumsum(ODD_SIZES)[:-1])
ODD_IN = sum(ODD_SIZES)
ODD_MIX = ML_WIDTH + MLA_WIDTH
XA_HEADS = 4
XA_HEAD_DIM = 128
XA_WIDTH = XA_HEADS * XA_HEAD_DIM
FFN_HIDDEN = ((8 * D_MODEL + 3 * 256 - 1) // (3 * 256)) * 256
N_EVEN = (DEPTH + 1) // 2
N_ODD = DEPTH // 2

kernel_name = 'hybrid_conv_pool_mlstm_mla_trunk'


def rmsnorm(x, g):
    xf = x.astype(jnp.float32)
    y = xf * lax.rsqrt(jnp.mean(xf * xf, axis=-1, keepdims=True) + EPS)
    return (y * g.astype(jnp.float32)).astype(x.dtype)


def causal_dwconv(u, w):
    c = u.shape[-1]
    return lax.conv_general_dilated(u, w[:, None, :].astype(u.dtype), window_strides=(1,),
                                    padding=[(CONV_K - 1, 0)],
                                    dimension_numbers=('NWC', 'WIO', 'NWC'),
                                    feature_group_count=c)


def causal_pool_mixer(u, pool_w, pool_scale):
    B, S, _ = u.shape
    ug = u.reshape(B, S, len(POOL_WINDOWS), POOL_GROUP)
    csum = jnp.cumsum(ug.astype(jnp.float32), axis=1)
    t1 = jnp.arange(1, S + 1)
    means = []
    for gi, w in enumerate(POOL_WINDOWS):
        cg = csum[:, :, gi]
        shifted = jnp.pad(cg, ((0, 0), (w, 0), (0, 0)))[:, :S]
        cnt = jnp.minimum(t1, w).astype(jnp.float32)
        means.append((cg - shifted) / cnt[None, :, None])
    pooled = jnp.stack(means, axis=2).astype(u.dtype)
    y = jnp.einsum('bsgc,gcd->bsgd', pooled - ug, pool_w)
    return y.reshape(B, S, POOL_WIDTH) * pool_scale


def even_mixer(h, w_in, conv_w, pool_w, pool_scale, w_out):
    z = h @ w_in
    g_b, g_c, xa, xb = jnp.split(z, [SC_WIDTH, 2 * SC_WIDTH, 3 * SC_WIDTH], axis=-1)
    ya = g_b * causal_dwconv(g_c * xa, conv_w)
    yb = causal_pool_mixer(xb, pool_w, pool_scale)
    return jnp.concatenate([ya, yb], axis=-1) @ w_out


def mlstm_chunkwise(q, k, v, i_pre, f_pre):
    B, S, H, D = q.shape
    L = ML_CHUNK
    NC = S // L

    def chunk(t):
        return t.reshape(B, NC, L, H, D).transpose(0, 3, 1, 2, 4)

    def chunk_g(t):
        return t.reshape(B, NC, L, H).transpose(0, 3, 1, 2)

    qc, kc, vc = chunk(q), chunk(k) * (D ** -0.5), chunk(v)
    ig = chunk_g(i_pre)
    bcum = jnp.cumsum(chunk_g(jax.nn.log_sigmoid(f_pre)), axis=-1)
    gtot = bcum[..., -1]

    a = gtot[..., None] - bcum + ig
    m_loc = jnp.max(a, axis=-1)
    w_loc = jnp.exp(a - m_loc[..., None])
    C_loc = jnp.einsum('bhcl,bhclv,bhclk->bhcvk', w_loc, vc, kc)
    n_loc = jnp.einsum('bhcl,bhclk->bhck', w_loc, kc)

    def step(carry, xs):
        C, n, m = carry
        g_c, m_l, C_l, n_l = xs
        m_new = jnp.maximum(g_c + m, m_l)
        s_old = jnp.exp(g_c + m - m_new)
        s_new = jnp.exp(m_l - m_new)
        C_new = s_old[..., None, None] * C + s_new[..., None, None] * C_l
        n_new = s_old[..., None] * n + s_new[..., None] * n_l
        return (C_new, n_new, m_new), (C, n, m)

    init = (jnp.zeros((B, H, D, D), jnp.float32), jnp.zeros((B, H, D), jnp.float32),
            jnp.zeros((B, H), jnp.float32))
    xs = (jnp.moveaxis(gtot, 2, 0), jnp.moveaxis(m_loc, 2, 0),
          jnp.moveaxis(C_loc, 2, 0), jnp.moveaxis(n_loc, 2, 0))
    _, (C_prev, n_prev, m_prev) = lax.scan(step, init, xs)
    C_prev = jnp.moveaxis(C_prev, 0, 2)
    n_prev = jnp.moveaxis(n_prev, 0, 2)
    m_prev = jnp.moveaxis(m_prev, 0, 2)

    causal = jnp.tril(jnp.ones((L, L), dtype=bool))
    dmat = jnp.where(causal, bcum[..., :, None] - bcum[..., None, :] + ig[..., None, :], -jnp.inf)
    inter = bcum + m_prev[..., None]
    m_t = jnp.maximum(inter, jnp.max(dmat, axis=-1))
    w_intra = jnp.exp(dmat - m_t[..., None])
    w_inter = jnp.exp(inter - m_t)
    sw = w_intra * jnp.einsum('bhcld,bhcsd->bhcls', qc, kc)
    num = (w_inter[..., None] * jnp.einsum('bhcvk,bhclk->bhclv', C_prev, qc)
           + jnp.einsum('bhcls,bhcsv->bhclv', sw, vc))
    den_raw = w_inter * jnp.einsum('bhck,bhclk->bhcl', n_prev, qc) + jnp.sum(sw, axis=-1)
    den = jnp.maximum(jnp.abs(den_raw), jnp.exp(-m_t))
    hc = num / den[..., None]
    return hc.transpose(0, 2, 3, 1, 4).reshape(B, S, H, D)


def rope_tables(positions):
    half = QK_ROPE // 2
    inv_freq = ROPE_THETA ** (-jnp.arange(half, dtype=jnp.float32) / half)
    ang = positions.astype(jnp.float32)[..., None] * inv_freq
    return jnp.cos(ang)[:, :, None, :], jnp.sin(ang)[:, :, None, :]


def apply_rope(t, cos, sin):
    half = t.shape[-1] // 2
    tf = t.astype(jnp.float32)
    t1, t2 = tf[..., :half], tf[..., half:]
    return jnp.concatenate([t1 * cos - t2 * sin, t1 * sin + t2 * cos], axis=-1).astype(t.dtype)


def mla_attention(q_nope, q_rope, k_nope, k_rope, v):
    B, S, H, _ = q_nope.shape
    nb = S // Q_BLOCK
    scale = (QK_NOPE + QK_ROPE) ** -0.5
    k_idx = jnp.arange(S)

    def to_blocks(t):
        return jnp.moveaxis(t.reshape(B, nb, Q_BLOCK, H, t.shape[-1]), 1, 0)

    def attend_block(args):
        blk, qn, qr = args
        s = (jnp.einsum('bqhd,bkhd->bhqk', qn, k_nope)
             + jnp.einsum('bqhr,bkr->bhqk', qr, k_rope)).astype(jnp.float32) * scale
        q_idx = blk * Q_BLOCK + jnp.arange(Q_BLOCK)
        s = jnp.where(k_idx[None, :] <= q_idx[:, None], s, -jnp.inf)
        p = jax.nn.softmax(s, axis=-1).astype(v.dtype)
        return jnp.einsum('bhqk,bkhd->bqhd', p, v)

    out = lax.map(attend_block, (jnp.arange(nb), to_blocks(q_nope), to_blocks(q_rope)))
    return jnp.moveaxis(out, 0, 1).reshape(B, S, H * V_DIM)


def odd_mixer(h, positions, w_in, gate_bias, ml_norm_g, q_norm_g, kv_norm_g, w_uq, w_ukv, w_out):
    B, S, _ = h.shape
    z = h @ w_in
    q_m, k_m, v_m, o_m, gates, c_q, c_kv, k_r = jnp.split(z, ODD_SPLIT, axis=-1)
    gates = (gates + gate_bias).astype(jnp.float32)
    i_pre, f_pre = gates[..., :ML_HEADS], gates[..., ML_HEADS:]
    hs = (B, S, ML_HEADS, ML_HEAD_DIM)
    hm = mlstm_chunkwise(q_m.reshape(hs).astype(jnp.float32), k_m.reshape(hs).astype(jnp.float32),
                         v_m.reshape(hs).astype(jnp.float32), i_pre, f_pre).astype(h.dtype)
    hm = jax.nn.sigmoid(o_m).reshape(hs) * hm
    hm = rmsnorm(hm, ml_norm_g.reshape(ML_HEADS, ML_HEAD_DIM)).reshape(B, S, ML_WIDTH)

    q = (rmsnorm(c_q, q_norm_g) @ w_uq).reshape(B, S, MLA_HEADS, QK_NOPE + QK_ROPE)
    kv = (rmsnorm(c_kv, kv_norm_g) @ w_ukv).reshape(B, S, MLA_HEADS, QK_NOPE + V_DIM)
    cos, sin = rope_tables(positions)
    q_nope, q_rope = q[..., :QK_NOPE], apply_rope(q[..., QK_NOPE:], cos, sin)
    k_nope, v = kv[..., :QK_NOPE], kv[..., QK_NOPE:]
    k_rope = apply_rope(k_r[:, :, None, :], cos, sin)[:, :, 0]
    ha = mla_attention(q_nope, q_rope, k_nope, k_rope, v)
    return jnp.concatenate([hm, ha], axis=-1) @ w_out


def memory_cross_attention(h, mem_n, wq, wkv, wo):
    B, S, _ = h.shape
    q = (h @ wq).reshape(B, S, XA_HEADS, XA_HEAD_DIM)
    k, v = jnp.split(mem_n @ wkv, 2, axis=-1)
    k = k.reshape(B, N_MEM, XA_HEADS, XA_HEAD_DIM)
    v = v.reshape(B, N_MEM, XA_HEADS, XA_HEAD_DIM)
    s = jnp.einsum('bshd,bmhd->bhsm', q, k).astype(jnp.float32) * (XA_HEAD_DIM ** -0.5)
    p = jax.nn.softmax(s, axis=-1).astype(v.dtype)
    return jnp.einsum('bhsm,bmhd->bshd', p, v).reshape(B, S, XA_WIDTH) @ wo


def swiglu(h, w_gate_up, w_down):
    g, u = jnp.split(h @ w_gate_up, 2, axis=-1)
    return (jax.nn.silu(g) * u) @ w_down


def setup_inputs(seed: int = 0) -> dict:
    key = jax.random.key(seed)
    ks = iter(jax.random.split(key, 40))
    f32 = jnp.float32

    def dense(shape, fan_in):
        return jax.random.normal(next(ks), shape, f32) * (fan_in ** -0.5)

    def gain(shape):
        return 1.0 + 0.05 * jax.random.normal(next(ks), shape, f32)

    x = jax.random.normal(next(ks), (BATCH, SEQ, D_MODEL), f32)
    mem = jax.random.normal(next(ks), (BATCH, N_MEM, D_MODEL), f32)
    offsets = jax.random.randint(next(ks), (BATCH, 1), 0, 1024, dtype=jnp.int32)
    positions = offsets + jnp.arange(SEQ, dtype=jnp.int32)[None, :]

    f_bias = jnp.linspace(3.0, 6.0, ML_HEADS, dtype=f32)[None, :] + 0.1 * jax.random.normal(next(ks), (N_ODD, ML_HEADS), f32)
    i_bias = 0.1 * jax.random.normal(next(ks), (N_ODD, ML_HEADS), f32)

    return {
        'x': x,
        'mem': mem,
        'positions': positions,
        'norm_mix_g': gain((DEPTH, D_MODEL)),
        'norm_xattn_g': gain((DEPTH, D_MODEL)),
        'mem_norm_g': gain((DEPTH, D_MODEL)),
        'xattn_wq': dense((DEPTH, D_MODEL, XA_WIDTH), D_MODEL),
        'xattn_wkv': dense((DEPTH, D_MODEL, 2 * XA_WIDTH), D_MODEL),
        'xattn_wo': dense((DEPTH, XA_WIDTH, D_MODEL), XA_WIDTH),
        'norm_ffn_g': gain((DEPTH, D_MODEL)),
        'ffn_w_gate_up': dense((DEPTH, D_MODEL, 2 * FFN_HIDDEN), D_MODEL),
        'ffn_w_down': dense((DEPTH, FFN_HIDDEN, D_MODEL), FFN_HIDDEN),
        'ev_w_in': dense((N_EVEN, D_MODEL, EVEN_IN), D_MODEL),
        'ev_conv_w': dense((N_EVEN, CONV_K, SC_WIDTH), CONV_K),
        'ev_pool_w': dense((N_EVEN, len(POOL_WINDOWS), POOL_GROUP, POOL_GROUP), POOL_GROUP),
        'ev_pool_scale': 1.0 + 0.1 * jax.random.normal(next(ks), (N_EVEN, POOL_WIDTH), f32),
        'ev_w_out': dense((N_EVEN, EVEN_MIX, D_MODEL), EVEN_MIX),
        'od_w_in': dense((N_ODD, D_MODEL, ODD_IN), D_MODEL),
        'od_gate_bias': jnp.concatenate([i_bias, f_bias], axis=-1),
        'od_ml_norm_g': gain((N_ODD, ML_WIDTH)),
        'od_q_norm_g': gain((N_ODD, Q_LORA)),
        'od_kv_norm_g': gain((N_ODD, KV_LORA)),
        'od_w_uq': dense((N_ODD, Q_LORA, MLA_HEADS * (QK_NOPE + QK_ROPE)), Q_LORA),
        'od_w_ukv': dense((N_ODD, KV_LORA, MLA_HEADS * (QK_NOPE + V_DIM)), KV_LORA),
        'od_w_out': dense((N_ODD, ODD_MIX, D_MODEL), ODD_MIX),
        'final_norm_g': gain((D_MODEL,)),
    }


def reference(x, mem, positions, norm_mix_g, norm_xattn_g, mem_norm_g, xattn_wq, xattn_wkv, xattn_wo,
              norm_ffn_g, ffn_w_gate_up, ffn_w_down, ev_w_in, ev_conv_w, ev_pool_w, ev_pool_scale,
              ev_w_out, od_w_in, od_gate_bias, od_ml_norm_g, od_q_norm_g, od_kv_norm_g, od_w_uq,
              od_w_ukv, od_w_out, final_norm_g):
    for layer in range(DEPTH):
        h = rmsnorm(x, norm_mix_g[layer])
        if layer % 2 == 0:
            e = layer // 2
            mix = even_mixer(h, ev_w_in[e], ev_conv_w[e], ev_pool_w[e], ev_pool_scale[e], ev_w_out[e])
        else:
            o = layer // 2
            mix = odd_mixer(h, positions, od_w_in[o], od_gate_bias[o], od_ml_norm_g[o], od_q_norm_g[o],
                            od_kv_norm_g[o], od_w_uq[o], od_w_ukv[o], od_w_out[o])
        x = x + mix
        mem_n = rmsnorm(mem, mem_norm_g[layer])
        x = x + memory_cross_attention(rmsnorm(x, norm_xattn_g[layer]), mem_n,
                                       xattn_wq[layer], xattn_wkv[layer], xattn_wo[layer])
        x = x + swiglu(rmsnorm(x, norm_ffn_g[layer]), ffn_w_gate_up[layer], ffn_w_down[layer])
    return rmsnorm(x, final_norm_g)
```

```cpp
#include <hip/hip_runtime.h>
#include <cstdio>
#include <cstdint>
#include <cmath>
typedef unsigned short bf16_t;
constexpr int BATCH = 4, SEQ = 4096, DM = 1024, MTOK = BATCH * SEQ, NMEM = 256;
constexpr int FFH = 2816, ODD_IN = 2728;
constexpr size_t MiB = 1u << 20;
constexpr size_t WS_CTL = 0;
constexpr size_t WS_SSQ = 1 * MiB;
constexpr size_t WS_GATES = 3 * MiB;
constexpr size_t WS_FCUM = 3 * MiB + 512 * 1024;
constexpr size_t WS_MEMN = 4 * MiB;
constexpr size_t WS_MEMKV = 6 * MiB;
constexpr size_t WS_WB = 10 * MiB;
constexpr size_t WS_Z = 70 * MiB;
constexpr size_t WS_YMIX = 158 * MiB;
constexpr size_t WS_XB = 190 * MiB;
constexpr size_t WS_EXT = 222 * MiB;
constexpr size_t WS_END = 256 * MiB;
namespace nv {
__device__ __forceinline__ float bf2f(bf16_t v) { return __uint_as_float(((unsigned)v) << 16); }
__device__ __forceinline__ bf16_t f2bf(float f) { unsigned u = __float_as_uint(f); return (bf16_t)((u + 0x7fffu + ((u >> 16) & 1u)) >> 16); }
__device__ __forceinline__ float ldf(const float* p) { return *p; }
__device__ __forceinline__ float ldf(const bf16_t* p) { return bf2f(*p); }
__device__ __forceinline__ float wsum(float v) {
#pragma unroll
    for (int o = 1; o < 64; o <<= 1) v += __shfl_xor(v, o);
    return v;
}
__device__ __forceinline__ float wmax(float v) {
#pragma unroll
    for (int o = 1; o < 64; o <<= 1) v = fmaxf(v, __shfl_xor(v, o));
    return v;
}

__global__ void __launch_bounds__(256) copy_f32(const float* a, float* b, size_t n) {
    for (size_t i = (size_t)blockIdx.x * 256 + threadIdx.x; i < n; i += (size_t)gridDim.x * 256) b[i] = a[i];
}

template <typename TIN, typename TOUT>
__global__ void __launch_bounds__(256) rmsnorm(const TIN* x, int ldx, const float* g, TOUT* out, int ldo, int rows, int width) {
    const int row = blockIdx.x * 4 + (threadIdx.x >> 6), lane = threadIdx.x & 63;
    if (row >= rows) return;
    const TIN* xr = x + (size_t)row * ldx;
    float ss = 0.f;
    for (int c = lane; c < width; c += 64) { const float v = ldf(xr + c); ss += v * v; }
    ss = wsum(ss);
    const float rstd = rsqrtf(ss / (float)width + 1e-6f);
    for (int c = lane; c < width; c += 64) {
        const float v = ldf(xr + c) * rstd * g[c];
        if constexpr (sizeof(TOUT) == 2) out[(size_t)row * ldo + c] = f2bf(v); else out[(size_t)row * ldo + c] = v;
    }
}

template <int EPI>
__global__ void __launch_bounds__(256) gemm(const bf16_t* A, int lda, const float* W, int ldw, int M, int N, int K, void* Cv, int ldc, const float* aux, int w2off) {
    __shared__ float As[16][64];
    __shared__ float Ws[16][64];
    __shared__ float Ws2[16][64];
    const int tx = threadIdx.x & 15, ty = threadIdx.x >> 4;
    const int m0 = blockIdx.y * 64, n0 = blockIdx.x * 64;
    float acc[4][4], acc2[4][4];
#pragma unroll
    for (int i = 0; i < 4; ++i)
#pragma unroll
        for (int j = 0; j < 4; ++j) { acc[i][j] = 0.f; acc2[i][j] = 0.f; }
    for (int k0 = 0; k0 < K; k0 += 16) {
#pragma unroll
        for (int i = 0; i < 4; ++i) {
            const int idx = threadIdx.x + i * 256;
            { const int r = idx >> 4, kk = idx & 15; As[kk][r] = bf2f(A[(size_t)(m0 + r) * lda + k0 + kk]); }
            { const int kk = idx >> 6, c = idx & 63;
              Ws[kk][c] = (n0 + c < N) ? W[(size_t)(k0 + kk) * ldw + n0 + c] : 0.f;
              if (EPI == 2) Ws2[kk][c] = (n0 + c < N) ? W[(size_t)(k0 + kk) * ldw + w2off + n0 + c] : 0.f; }
        }
        __syncthreads();
#pragma unroll
        for (int kk = 0; kk < 16; ++kk) {
            float a[4], b[4], b2[4];
#pragma unroll
            for (int i = 0; i < 4; ++i) { a[i] = As[kk][ty * 4 + i]; b[i] = Ws[kk][tx * 4 + i]; b2[i] = (EPI == 2) ? Ws2[kk][tx * 4 + i] : 0.f; }
#pragma unroll
            for (int i = 0; i < 4; ++i)
#pragma unroll
                for (int j = 0; j < 4; ++j) { acc[i][j] += a[i] * b[j]; if (EPI == 2) acc2[i][j] += a[i] * b2[j]; }
        }
        __syncthreads();
    }
#pragma unroll
    for (int i = 0; i < 4; ++i)
#pragma unroll
        for (int j = 0; j < 4; ++j) {
            const int row = m0 + ty * 4 + i, col = n0 + tx * 4 + j;
            if (col >= N) continue;
            const float v = acc[i][j];
            if (EPI == 0) ((bf16_t*)Cv)[(size_t)row * ldc + col] = f2bf(v);
            if (EPI == 1) ((float*)Cv)[(size_t)row * ldc + col] += v;
            if (EPI == 2) { const float u = acc2[i][j]; ((bf16_t*)Cv)[(size_t)row * ldc + col] = f2bf(v / (1.f + __expf(-v)) * u); }
            if (EPI == 3) ((bf16_t*)Cv)[(size_t)row * ldc + col] = f2bf(v * aux[col]);
            if (EPI == 4) ((float*)Cv)[(size_t)row * ldc + col] = v + aux[col];
        }
}

__global__ void __launch_bounds__(256) evenmix_local(const bf16_t* z, const float* conv_w, bf16_t* ymix, bf16_t* dscr) {
    const size_t idx = (size_t)blockIdx.x * 256 + threadIdx.x;
    const int c = (int)(idx & 511); const int row = (int)(idx >> 9); const int tt = row & (SEQ - 1);
    const bf16_t* zr = z + (size_t)row * 2048;
    float acc = 0.f;
#pragma unroll
    for (int k = 0; k < 3; ++k) { const int d = 2 - k; if (tt - d >= 0) { const bf16_t* zp = zr - (size_t)d * 2048; acc += conv_w[k * 512 + c] * (bf2f(zp[512 + c]) * bf2f(zp[1024 + c])); } }
    ymix[(size_t)row * 1024 + c] = f2bf(bf2f(zr[c]) * acc);
    const int gi = c >> 7, w = 2 << gi; const int cnt = (tt + 1 < w) ? tt + 1 : w;
    float s = 0.f;
    for (int j = 0; j < cnt; ++j) s += bf2f((zr - (size_t)j * 2048)[1536 + c]);
    dscr[(size_t)row * 512 + c] = f2bf(s / (float)cnt - bf2f(zr[1536 + c]));
}

__global__ void fcum_kernel(const float* gates, float* fcum) {
    const int id = blockIdx.x * blockDim.x + threadIdx.x; if (id >= BATCH * 4) return;
    const int b = id >> 2, h = id & 3; float s = 0.f;
    for (int t = 0; t < SEQ; ++t) { const size_t row = (size_t)b * SEQ + t; const float f = gates[row * 8 + 4 + h];
        const float ls = fminf(f, 0.f) - log1pf(__expf(-fabsf(f))); s += ls; fcum[row * 4 + h] = s; }
}

__global__ void __launch_bounds__(256) mla_pack(const bf16_t* qraw, const bf16_t* kvraw, const bf16_t* z1aux, const int* positions, bf16_t* QM, bf16_t* KM, bf16_t* VM) {
    const size_t idx = (size_t)blockIdx.x * 256 + threadIdx.x;
    const int col = (int)(idx % 768); const size_t row = idx / 768;
    const int h = col / 96, j = col % 96;
    const float pos = (float)positions[row];
    if (j < 64) { QM[row * 768 + col] = qraw[row * 768 + col]; KM[row * 768 + col] = kvraw[row * 1024 + h * 128 + j]; VM[row * 512 + h * 64 + j] = kvraw[row * 1024 + h * 128 + 64 + j]; }
    else {
        const int r = j - 64, i = r & 15;
        const float inv = powf(10000.0f, -(float)i / 16.0f); const float ang = pos * inv; const float cs = cosf(ang), sn = sinf(ang);
        { const float t1 = bf2f(qraw[row * 768 + h * 96 + 64 + i]), t2 = bf2f(qraw[row * 768 + h * 96 + 80 + i]); QM[row * 768 + col] = f2bf(r < 16 ? t1 * cs - t2 * sn : t1 * sn + t2 * cs); }
        { const float t1 = bf2f(z1aux[row * 768 + 640 + i]), t2 = bf2f(z1aux[row * 768 + 656 + i]); KM[row * 768 + col] = f2bf(r < 16 ? t1 * cs - t2 * sn : t1 * sn + t2 * cs); }
    }
}

template <int MODE, int DK, int DV>
__global__ void __launch_bounds__(256) attn(const bf16_t* Q, int ldq, const bf16_t* Kp, int ldk, const bf16_t* Vp, int ldv, bf16_t* O, int ldo,
                                            int Sq, int Sk, int H, int causal, float scale, const float* fcum, const float* gates, const bf16_t* ogate, int ldg, const float* normg) {
    __shared__ float qs[4][DK];
    const int wv = threadIdx.x >> 6, lane = threadIdx.x & 63;
    const size_t w = (size_t)blockIdx.x * 4 + wv;
    const int t = (int)(w % Sq); const int h = (int)((w / Sq) % H); const int b = (int)(w / ((size_t)Sq * H));
    const size_t qrow = (size_t)b * Sq + t;
    for (int d = lane; d < DK; d += 64) qs[wv][d] = bf2f(Q[qrow * ldq + h * DK + d]);
    __syncthreads();
    const int nk = causal ? t + 1 : Sk;
    float m = -INFINITY, l = 0.f; float acc[(DV + 63) / 64];
#pragma unroll
    for (int i = 0; i < (DV + 63) / 64; ++i) acc[i] = 0.f;
    const float Ft = (MODE == 1) ? fcum[qrow * 4 + h] : 0.f;
    for (int s0 = 0; s0 < nk; s0 += 64) {
        const int s = s0 + lane; const bool ok = s < nk; const size_t krow = (size_t)b * Sk + (ok ? s : 0);
        float sc = 0.f;
        const bf16_t* kr = Kp + krow * ldk + h * DK;
        for (int d = 0; d < DK; ++d) sc += qs[wv][d] * bf2f(kr[d]);
        sc *= scale;
        float a;
        if (MODE == 1) a = ok ? (Ft - fcum[krow * 4 + h] + gates[krow * 8 + h]) : -INFINITY; else a = ok ? sc : -INFINITY;
        const float mb = wmax(a); const float mn = fmaxf(m, mb);
        const float f = __expf(m - mn);
        float p = ok ? __expf(a - mn) : 0.f; if (MODE == 1) p *= sc;
        l = l * f + wsum(p);
#pragma unroll
        for (int i = 0; i < (DV + 63) / 64; ++i) acc[i] *= f;
        const int cntk = (nk - s0 < 64) ? nk - s0 : 64;
        for (int j = 0; j < cntk; ++j) {
            const float pj = __shfl(p, j); const bf16_t* vr = Vp + ((size_t)b * Sk + s0 + j) * ldv + h * DV;
#pragma unroll
            for (int i = 0; i < (DV + 63) / 64; ++i) { const int d = lane + 64 * i; if (d < DV) acc[i] += pj * bf2f(vr[d]); }
        }
        m = mn;
    }
    if (MODE == 0) {
#pragma unroll
        for (int i = 0; i < (DV + 63) / 64; ++i) { const int d = lane + 64 * i; if (d < DV) O[qrow * ldo + h * DV + d] = f2bf(acc[i] / l); }
    } else {
        const float den = fmaxf(fabsf(l), __expf(-m)); float hv[(DV + 63) / 64]; float ss = 0.f;
#pragma unroll
        for (int i = 0; i < (DV + 63) / 64; ++i) { const int d = lane + 64 * i; const float og = bf2f(ogate[qrow * ldg + h * DV + d]);
            hv[i] = (acc[i] / den) / (1.f + __expf(-og)); ss += hv[i] * hv[i]; }
        ss = wsum(ss); const float rstd = rsqrtf(ss / (float)DV + 1e-6f);
#pragma unroll
        for (int i = 0; i < (DV + 63) / 64; ++i) { const int d = lane + 64 * i; O[qrow * ldo + h * DV + d] = f2bf(hv[i] * rstd * normg[h * DV + d]); }
    }
}
}
struct In {
    const float *x, *mem; const int* pos; const float *norm_mix_g, *norm_xattn_g, *mem_norm_g, *xattn_wq, *xattn_wkv, *xattn_wo, *norm_ffn_g, *ffn_gu, *ffn_down,
        *ev_w_in, *ev_conv_w, *ev_pool_w, *ev_pool_scale, *ev_w_out, *od_w_in, *od_gate_bias, *od_ml_norm_g, *od_q_norm_g, *od_kv_norm_g, *od_w_uq, *od_w_ukv, *od_w_out, *final_norm_g;
};
static void naive_xattn_ffn(const In& I, int l, float* X, unsigned char* ws, hipStream_t st) {
    bf16_t* XB = (bf16_t*)(ws + WS_XB); bf16_t* QX = (bf16_t*)(ws + WS_Z); bf16_t* OX = (bf16_t*)(ws + WS_Z + 16 * MiB); bf16_t* HB = (bf16_t*)(ws + WS_Z);
    const bf16_t* MKV = (const bf16_t*)(ws + WS_MEMKV) + (size_t)l * 1024 * 1024;
    nv::rmsnorm<float, bf16_t><<<MTOK / 4, 256, 0, st>>>(X, DM, I.norm_xattn_g + l * DM, XB, DM, MTOK, DM);
    nv::gemm<0><<<dim3(512 / 64, MTOK / 64), 256, 0, st>>>(XB, DM, I.xattn_wq + (size_t)l * DM * 512, 512, MTOK, 512, DM, QX, 512, nullptr, 0);
    nv::attn<0, 128, 128><<<MTOK * 4 / 4, 256, 0, st>>>(QX, 512, MKV, 1024, MKV + 512, 1024, OX, 512, SEQ, NMEM, 4, 0, 0.08838834764831845f, nullptr, nullptr, nullptr, 0, nullptr);
    nv::gemm<1><<<dim3(DM / 64, MTOK / 64), 256, 0, st>>>(OX, 512, I.xattn_wo + (size_t)l * 512 * DM, DM, MTOK, DM, 512, X, DM, nullptr, 0);
    nv::rmsnorm<float, bf16_t><<<MTOK / 4, 256, 0, st>>>(X, DM, I.norm_ffn_g + l * DM, XB, DM, MTOK, DM);
    nv::gemm<2><<<dim3(FFH / 64, MTOK / 64), 256, 0, st>>>(XB, DM, I.ffn_gu + (size_t)l * DM * 2 * FFH, 2 * FFH, MTOK, FFH, DM, HB, FFH, nullptr, FFH);
    nv::gemm<1><<<dim3(DM / 64, MTOK / 64), 256, 0, st>>>(HB, FFH, I.ffn_down + (size_t)l * FFH * DM, DM, MTOK, DM, FFH, X, DM, nullptr, 0);
}
static void naive_forward(const In& I, float* X, unsigned char* ws, hipStream_t st) {
    bf16_t* XB = (bf16_t*)(ws + WS_XB); bf16_t* Z = (bf16_t*)(ws + WS_Z); bf16_t* YMIX = (bf16_t*)(ws + WS_YMIX);
    bf16_t* MEMN = (bf16_t*)(ws + WS_MEMN); bf16_t* MKV = (bf16_t*)(ws + WS_MEMKV);
    float* GATES = (float*)(ws + WS_GATES); float* FCUM = (float*)(ws + WS_FCUM);
    nv::copy_f32<<<2048, 256, 0, st>>>(I.x, X, (size_t)MTOK * DM);
    for (int l = 0; l < 2; ++l) {
        nv::rmsnorm<float, bf16_t><<<1024 / 4, 256, 0, st>>>(I.mem, DM, I.mem_norm_g + l * DM, MEMN, DM, 1024, DM);
        nv::gemm<0><<<dim3(1024 / 64, 1024 / 64), 256, 0, st>>>(MEMN, DM, I.xattn_wkv + (size_t)l * DM * 1024, 1024, 1024, 1024, DM, MKV + (size_t)l * 1024 * 1024, 1024, nullptr, 0);
    }
    nv::rmsnorm<float, bf16_t><<<MTOK / 4, 256, 0, st>>>(X, DM, I.norm_mix_g, XB, DM, MTOK, DM);
    nv::gemm<0><<<dim3(2048 / 64, MTOK / 64), 256, 0, st>>>(XB, DM, I.ev_w_in, 2048, MTOK, 2048, DM, Z, 2048, nullptr, 0);
    nv::evenmix_local<<<MTOK * 512 / 256, 256, 0, st>>>(Z, I.ev_conv_w, YMIX, XB  );
    for (int gi = 0; gi < 4; ++gi)
        nv::gemm<3><<<dim3(128 / 64, MTOK / 64), 256, 0, st>>>(XB + gi * 128, 512, I.ev_pool_w + (size_t)gi * 128 * 128, 128, MTOK, 128, 128, YMIX + 512 + gi * 128, DM, I.ev_pool_scale + gi * 128, 0);
    nv::gemm<1><<<dim3(DM / 64, MTOK / 64), 256, 0, st>>>(YMIX, DM, I.ev_w_out, DM, MTOK, DM, DM, X, DM, nullptr, 0);
    naive_xattn_ffn(I, 0, X, ws, st);
    bf16_t* Z1M = Z; bf16_t* Z1A = Z + (size_t)MTOK * 2048;
    nv::rmsnorm<float, bf16_t><<<MTOK / 4, 256, 0, st>>>(X, DM, I.norm_mix_g + DM, XB, DM, MTOK, DM);
    nv::gemm<0><<<dim3(2048 / 64, MTOK / 64), 256, 0, st>>>(XB, DM, I.od_w_in, ODD_IN, MTOK, 2048, DM, Z1M, 2048, nullptr, 0);
    nv::gemm<4><<<dim3(1, MTOK / 64), 256, 0, st>>>(XB, DM, I.od_w_in + 2048, ODD_IN, MTOK, 8, DM, GATES, 8, I.od_gate_bias, 0);
    nv::gemm<0><<<dim3((672 + 63) / 64, MTOK / 64), 256, 0, st>>>(XB, DM, I.od_w_in + 2056, ODD_IN, MTOK, 672, DM, Z1A, 768, nullptr, 0);
    nv::fcum_kernel<<<1, 64, 0, st>>>(GATES, FCUM);
    nv::attn<1, 128, 128><<<MTOK * 4 / 4, 256, 0, st>>>(Z1M, 2048, Z1M + 512, 2048, Z1M + 1024, 2048, YMIX, DM, SEQ, SEQ, 4, 1, 0.08838834764831845f, FCUM, GATES, Z1M + 1536, 2048, I.od_ml_norm_g);
    bf16_t* S1 = XB; bf16_t* S2 = XB + (size_t)MTOK * 384; bf16_t* QRAW = Z1M; bf16_t* KVRAW = Z1M + (size_t)MTOK * 768;
    bf16_t* QM = (bf16_t*)(ws + WS_XB + 20 * MiB); bf16_t* KM = QM + (size_t)MTOK * 768; bf16_t* VM = KM + (size_t)MTOK * 768;
    (void)QM; (void)KM; (void)VM;
    nv::rmsnorm<bf16_t, bf16_t><<<MTOK / 4, 256, 0, st>>>(Z1A, 768, I.od_q_norm_g, S1, 384, MTOK, 384);
    nv::rmsnorm<bf16_t, bf16_t><<<MTOK / 4, 256, 0, st>>>(Z1A + 384, 768, I.od_kv_norm_g, S2, 256, MTOK, 256);
    nv::gemm<0><<<dim3(768 / 64, MTOK / 64), 256, 0, st>>>(S1, 384, I.od_w_uq, 768, MTOK, 768, 384, QRAW, 768, nullptr, 0);
    nv::gemm<0><<<dim3(1024 / 64, MTOK / 64), 256, 0, st>>>(S2, 256, I.od_w_ukv, 1024, MTOK, 1024, 256, KVRAW, 1024, nullptr, 0);
    bf16_t* QM2 = (bf16_t*)(ws + WS_XB); bf16_t* KM2 = QM2 + (size_t)MTOK * 768; bf16_t* VM2 = KM2 + (size_t)MTOK * 768;
    nv::mla_pack<<<MTOK * 768 / 256, 256, 0, st>>>(QRAW, KVRAW, Z1A, I.pos, QM2, KM2, VM2);
    nv::attn<0, 96, 64><<<MTOK * 8 / 4, 256, 0, st>>>(QM2, 768, KM2, 768, VM2, 512, YMIX + 512, DM, SEQ, SEQ, 8, 1, 0.10206207261596575f, nullptr, nullptr, nullptr, 0, nullptr);
    nv::gemm<1><<<dim3(DM / 64, MTOK / 64), 256, 0, st>>>(YMIX, DM, I.od_w_out, DM, MTOK, DM, DM, X, DM, nullptr, 0);
    naive_xattn_ffn(I, 1, X, ws, st);
    nv::rmsnorm<float, float><<<MTOK / 4, 256, 0, st>>>(X, DM, I.final_norm_g, X, DM, MTOK, DM);
}

extern "C" void kernel_launch(void* const* d_in, const int* in_sizes, int n_in, void* d_out, int out_size, void* d_ws, size_t ws_size, hipStream_t stream) {
    if (n_in != 26 || out_size != MTOK * DM || ws_size < WS_END) { fprintf(stderr, "kernel_launch: unexpected shapes n_in %d out %d ws %zu\n", n_in, out_size, ws_size); return; }
    In I;
    I.x = (const float*)d_in[0]; I.mem = (const float*)d_in[1]; I.pos = (const int*)d_in[2]; I.norm_mix_g = (const float*)d_in[3]; I.norm_xattn_g = (const float*)d_in[4];
    I.mem_norm_g = (const float*)d_in[5]; I.xattn_wq = (const float*)d_in[6]; I.xattn_wkv = (const float*)d_in[7]; I.xattn_wo = (const float*)d_in[8]; I.norm_ffn_g = (const float*)d_in[9];
    I.ffn_gu = (const float*)d_in[10]; I.ffn_down = (const float*)d_in[11]; I.ev_w_in = (const float*)d_in[12]; I.ev_conv_w = (const float*)d_in[13]; I.ev_pool_w = (const float*)d_in[14];
    I.ev_pool_scale = (const float*)d_in[15]; I.ev_w_out = (const float*)d_in[16]; I.od_w_in = (const float*)d_in[17]; I.od_gate_bias = (const float*)d_in[18]; I.od_ml_norm_g = (const float*)d_in[19];
    I.od_q_norm_g = (const float*)d_in[20]; I.od_kv_norm_g = (const float*)d_in[21]; I.od_w_uq = (const float*)d_in[22]; I.od_w_ukv = (const float*)d_in[23]; I.od_w_out = (const float*)d_in[24];
    I.final_norm_g = (const float*)d_in[25];
    naive_forward(I, (float*)d_out, (unsigned char*)d_ws, stream);
}
```

```cpp
#include <hip/hip_runtime.h>
#include <cstdio>
#include <cstdint>
#include <cmath>
typedef unsigned short bf16_t;
constexpr int BATCH = 4, SEQ = 4096, DM = 1024, MTOK = BATCH * SEQ, NMEM = 256;
constexpr int FFH = 2816, ODD_IN = 2728;
constexpr size_t MiB = 1u << 20;
constexpr size_t WS_CTL = 0;
constexpr size_t WS_SSQ = 1 * MiB;
constexpr size_t WS_GATES = 3 * MiB;
constexpr size_t WS_FCUM = 3 * MiB + 512 * 1024;
constexpr size_t WS_MEMN = 4 * MiB;
constexpr size_t WS_MEMKV = 6 * MiB;
constexpr size_t WS_WB = 10 * MiB;
constexpr size_t WS_Z = 70 * MiB;
constexpr size_t WS_YMIX = 158 * MiB;
constexpr size_t WS_XB = 190 * MiB;
constexpr size_t WS_EXT = 222 * MiB;
constexpr size_t WS_END = 256 * MiB;
namespace nv {
__device__ __forceinline__ float bf2f(bf16_t v) { return __uint_as_float(((unsigned)v) << 16); }
__device__ __forceinline__ bf16_t f2bf(float f) { unsigned u = __float_as_uint(f); return (bf16_t)((u + 0x7fffu + ((u >> 16) & 1u)) >> 16); }
__device__ __forceinline__ float ldf(const float* p) { return *p; }
__device__ __forceinline__ float ldf(const bf16_t* p) { return bf2f(*p); }
__device__ __forceinline__ float wsum(float v) {
#pragma unroll
    for (int o = 1; o < 64; o <<= 1) v += __shfl_xor(v, o);
    return v;
}
__device__ __forceinline__ float wmax(float v) {
#pragma unroll
    for (int o = 1; o < 64; o <<= 1) v = fmaxf(v, __shfl_xor(v, o));
    return v;
}

__global__ void __launch_bounds__(256) copy_f32(const float* a, float* b, size_t n) {
    for (size_t i = (size_t)blockIdx.x * 256 + threadIdx.x; i < n; i += (size_t)gridDim.x * 256) b[i] = a[i];
}

template <typename TIN, typename TOUT>
__global__ void __launch_bounds__(256) rmsnorm(const TIN* x, int ldx, const float* g, TOUT* out, int ldo, int rows, int width) {
    const int row = blockIdx.x * 4 + (threadIdx.x >> 6), lane = threadIdx.x & 63;
    if (row >= rows) return;
    const TIN* xr = x + (size_t)row * ldx;
    float ss = 0.f;
    for (int c = lane; c < width; c += 64) { const float v = ldf(xr + c); ss += v * v; }
    ss = wsum(ss);
    const float rstd = rsqrtf(ss / (float)width + 1e-6f);
    for (int c = lane; c < width; c += 64) {
        const float v = ldf(xr + c) * rstd * g[c];
        if constexpr (sizeof(TOUT) == 2) out[(size_t)row * ldo + c] = f2bf(v); else out[(size_t)row * ldo + c] = v;
    }
}

__global__ void __launch_bounds__(256) xb_ssq(const float* x, bf16_t* xb, float* ssq) {
    const int row = blockIdx.x * 4 + (threadIdx.x >> 6), lane = threadIdx.x & 63; float ss = 0.f;
    for (int c = lane; c < DM; c += 64) { const float v = x[(size_t)row * DM + c]; ss += v * v; xb[(size_t)row * DM + c] = f2bf(v); }
    ss = wsum(ss); if (lane < 16) ssq[(size_t)row * 16 + lane] = lane == 0 ? ss : 0.f;
}
template <int EPI>
__global__ void __launch_bounds__(256) gemm(const bf16_t* A, int lda, const float* W, int ldw, int M, int N, int K, void* Cv, int ldc, const float* aux, int w2off) {
    __shared__ float As[16][64];
    __shared__ float Ws[16][64];
    __shared__ float Ws2[16][64];
    const int tx = threadIdx.x & 15, ty = threadIdx.x >> 4;
    const int m0 = blockIdx.y * 64, n0 = blockIdx.x * 64;
    float acc[4][4], acc2[4][4];
#pragma unroll
    for (int i = 0; i < 4; ++i)
#pragma unroll
        for (int j = 0; j < 4; ++j) { acc[i][j] = 0.f; acc2[i][j] = 0.f; }
    for (int k0 = 0; k0 < K; k0 += 16) {
#pragma unroll
        for (int i = 0; i < 4; ++i) {
            const int idx = threadIdx.x + i * 256;
            { const int r = idx >> 4, kk = idx & 15; As[kk][r] = bf2f(A[(size_t)(m0 + r) * lda + k0 + kk]); }
            { const int kk = idx >> 6, c = idx & 63;
              Ws[kk][c] = (n0 + c < N) ? W[(size_t)(k0 + kk) * ldw + n0 + c] : 0.f;
              if (EPI == 2) Ws2[kk][c] = (n0 + c < N) ? W[(size_t)(k0 + kk) * ldw + w2off + n0 + c] : 0.f; }
        }
        __syncthreads();
#pragma unroll
        for (int kk = 0; kk < 16; ++kk) {
            float a[4], b[4], b2[4];
#pragma unroll
            for (int i = 0; i < 4; ++i) { a[i] = As[kk][ty * 4 + i]; b[i] = Ws[kk][tx * 4 + i]; b2[i] = (EPI == 2) ? Ws2[kk][tx * 4 + i] : 0.f; }
#pragma unroll
            for (int i = 0; i < 4; ++i)
#pragma unroll
                for (int j = 0; j < 4; ++j) { acc[i][j] += a[i] * b[j]; if (EPI == 2) acc2[i][j] += a[i] * b2[j]; }
        }
        __syncthreads();
    }
#pragma unroll
    for (int i = 0; i < 4; ++i)
#pragma unroll
        for (int j = 0; j < 4; ++j) {
            const int row = m0 + ty * 4 + i, col = n0 + tx * 4 + j;
            if (col >= N) continue;
            const float v = acc[i][j];
            if (EPI == 0) ((bf16_t*)Cv)[(size_t)row * ldc + col] = f2bf(v);
            if (EPI == 1) ((float*)Cv)[(size_t)row * ldc + col] = aux[(size_t)row * ldc + col] + v;
            if (EPI == 2) { const float u = acc2[i][j]; ((bf16_t*)Cv)[(size_t)row * ldc + col] = f2bf(v / (1.f + __expf(-v)) * u); }
            if (EPI == 3) ((bf16_t*)Cv)[(size_t)row * ldc + col] = f2bf(v * aux[col]);
            if (EPI == 4) ((float*)Cv)[(size_t)row * ldc + col] = v + aux[col];
        }
}

__global__ void __launch_bounds__(256) evenmix_local(const bf16_t* z, const float* conv_w, bf16_t* ymix, bf16_t* dscr) {
    const size_t idx = (size_t)blockIdx.x * 256 + threadIdx.x;
    const int c = (int)(idx & 511); const int row = (int)(idx >> 9); const int tt = row & (SEQ - 1);
    const bf16_t* zr = z + (size_t)row * 2048;
    float acc = 0.f;
#pragma unroll
    for (int k = 0; k < 3; ++k) { const int d = 2 - k; if (tt - d >= 0) { const bf16_t* zp = zr - (size_t)d * 2048; acc += conv_w[k * 512 + c] * (bf2f(zp[512 + c]) * bf2f(zp[1024 + c])); } }
    ymix[(size_t)row * 1024 + c] = f2bf(bf2f(zr[c]) * acc);
    const int gi = c >> 7, w = 2 << gi; const int cnt = (tt + 1 < w) ? tt + 1 : w;
    float s = 0.f;
    for (int j = 0; j < cnt; ++j) s += bf2f((zr - (size_t)j * 2048)[1536 + c]);
    dscr[(size_t)row * 512 + c] = f2bf(s / (float)cnt - bf2f(zr[1536 + c]));
}

__global__ void fcum_kernel(const float* gates, float* fcum) {
    const int id = blockIdx.x * blockDim.x + threadIdx.x; if (id >= BATCH * 4) return;
    const int b = id >> 2, h = id & 3; float s = 0.f;
    for (int t = 0; t < SEQ; ++t) { const size_t row = (size_t)b * SEQ + t; const float f = gates[row * 8 + 4 + h];
        const float ls = fminf(f, 0.f) - log1pf(__expf(-fabsf(f))); s += ls; fcum[row * 4 + h] = s; }
}

__global__ void __launch_bounds__(256) copy_cols(const bf16_t* src, int lds_, bf16_t* dst, int ldd, int rows, int cols) {
    const size_t idx = (size_t)blockIdx.x * 256 + threadIdx.x; if (idx >= (size_t)rows * cols) return;
    const size_t r = idx / cols; const int c = (int)(idx % cols); dst[r * ldd + c] = src[r * lds_ + c];
}
__global__ void __launch_bounds__(256) mla_pack(const bf16_t* qraw, const bf16_t* kvraw, const bf16_t* kr, int ldkr, const int* positions, bf16_t* QM, bf16_t* KM, bf16_t* VM) {
    const size_t idx = (size_t)blockIdx.x * 256 + threadIdx.x;
    const int col = (int)(idx % 768); const size_t row = idx / 768;
    const int h = col / 96, j = col % 96;
    const float pos = (float)positions[row];
    if (j < 64) { QM[row * 768 + col] = qraw[row * 768 + col]; KM[row * 768 + col] = kvraw[row * 1024 + h * 128 + j]; VM[row * 512 + h * 64 + j] = kvraw[row * 1024 + h * 128 + 64 + j]; }
    else {
        const int r = j - 64, i = r & 15;
        const float inv = powf(10000.0f, -(float)i / 16.0f); const float ang = pos * inv; const float cs = cosf(ang), sn = sinf(ang);
        { const float t1 = bf2f(qraw[row * 768 + h * 96 + 64 + i]), t2 = bf2f(qraw[row * 768 + h * 96 + 80 + i]); QM[row * 768 + col] = f2bf(r < 16 ? t1 * cs - t2 * sn : t1 * sn + t2 * cs); }
        { const float t1 = bf2f(kr[row * ldkr + i]), t2 = bf2f(kr[row * ldkr + 16 + i]); KM[row * 768 + col] = f2bf(r < 16 ? t1 * cs - t2 * sn : t1 * sn + t2 * cs); }
    }
}

template <int MODE, int DK, int DV>
__global__ void __launch_bounds__(256) attn(const bf16_t* Q, int ldq, const bf16_t* Kp, int ldk, const bf16_t* Vp, int ldv, bf16_t* O, int ldo,
                                            int Sq, int Sk, int H, int causal, float scale, const float* fcum, const float* gates, const bf16_t* ogate, int ldg, const float* normg) {
    __shared__ float qs[4][DK];
    const int wv = threadIdx.x >> 6, lane = threadIdx.x & 63;
    const size_t w = (size_t)blockIdx.x * 4 + wv;
    const int t = (int)(w % Sq); const int h = (int)((w / Sq) % H); const int b = (int)(w / ((size_t)Sq * H));
    const size_t qrow = (size_t)b * Sq + t;
    for (int d = lane; d < DK; d += 64) qs[wv][d] = bf2f(Q[qrow * ldq + h * DK + d]);
    __syncthreads();
    const int nk = causal ? t + 1 : Sk;
    float m = -INFINITY, l = 0.f; float acc[(DV + 63) / 64];
#pragma unroll
    for (int i = 0; i < (DV + 63) / 64; ++i) acc[i] = 0.f;
    const float Ft = (MODE == 1) ? fcum[qrow * 4 + h] : 0.f;
    for (int s0 = 0; s0 < nk; s0 += 64) {
        const int s = s0 + lane; const bool ok = s < nk; const size_t krow = (size_t)b * Sk + (ok ? s : 0);
        float sc = 0.f;
        const bf16_t* kr = Kp + krow * ldk + h * DK;
        for (int d = 0; d < DK; ++d) sc += qs[wv][d] * bf2f(kr[d]);
        sc *= scale;
        float a;
        if (MODE == 1) a = ok ? (Ft - fcum[krow * 4 + h] + gates[krow * 8 + h]) : -INFINITY; else a = ok ? sc : -INFINITY;
        const float mb = wmax(a); const float mn = fmaxf(m, mb);
        const float f = __expf(m - mn);
        float p = ok ? __expf(a - mn) : 0.f; if (MODE == 1) p *= sc;
        l = l * f + wsum(p);
#pragma unroll
        for (int i = 0; i < (DV + 63) / 64; ++i) acc[i] *= f;
        const int cntk = (nk - s0 < 64) ? nk - s0 : 64;
        for (int j = 0; j < cntk; ++j) {
            const float pj = __shfl(p, j); const bf16_t* vr = Vp + ((size_t)b * Sk + s0 + j) * ldv + h * DV;
#pragma unroll
            for (int i = 0; i < (DV + 63) / 64; ++i) { const int d = lane + 64 * i; if (d < DV) acc[i] += pj * bf2f(vr[d]); }
        }
        m = mn;
    }
    if (MODE == 0) {
#pragma unroll
        for (int i = 0; i < (DV + 63) / 64; ++i) { const int d = lane + 64 * i; if (d < DV) O[qrow * ldo + h * DV + d] = f2bf(acc[i] / l); }
    } else {
        const float den = fmaxf(fabsf(l), __expf(-m)); float hv[(DV + 63) / 64]; float ss = 0.f;
#pragma unroll
        for (int i = 0; i < (DV + 63) / 64; ++i) { const int d = lane + 64 * i; const float og = bf2f(ogate[qrow * ldg + h * DV + d]);
            hv[i] = (acc[i] / den) / (1.f + __expf(-og)); ss += hv[i] * hv[i]; }
        ss = wsum(ss); const float rstd = rsqrtf(ss / (float)DV + 1e-6f);
#pragma unroll
        for (int i = 0; i < (DV + 63) / 64; ++i) { const int d = lane + 64 * i; O[qrow * ldo + h * DV + d] = f2bf(hv[i] * rstd * normg[h * DV + d]); }
    }
}
}
namespace pg8 {
#define PG8_LAS __attribute__((address_space(3)))
typedef unsigned short bf16_t;
typedef short bf16x8 __attribute__((ext_vector_type(8)));
typedef float f32x4 __attribute__((ext_vector_type(4)));
typedef unsigned u32x4 __attribute__((ext_vector_type(4)));
constexpr int BM = 256, BK = 64, HALF = 128, HTB = HALF * BK * 2  , STAGE_BYTES = 8 * HTB, NXCD = 8, WGM = 8;

__host__ __device__ __forceinline__ int lds_byte(int r, int c) { const int st = (r >> 4) * 2 + (c >> 5), rr = r & 15, cc = c & 31, ob = rr * 64 + cc * 2; return st * 1024 + (ob ^ (((ob >> 9) & 1) << 5)); }
__host__ __device__ __forceinline__ void stage_rc(int b, int& R, int& C) { const int st = b / 1024, sb = b % 1024, swz = sb ^ (((sb >> 9) & 1) << 5); R = (st >> 1) * 16 + swz / 64; C = (st & 1) * 32 + (swz % 64) / 2; }
__host__ __device__ __forceinline__ int perm32(int rho) { const int n = rho >> 4, i = rho & 15; return 8 * (i >> 2) + 4 * n + (i & 3); }

struct Unit { int pm, pn; };
struct Gemm { const bf16_t* A; const bf16_t* Bt; int M, N, K, lda; };

struct StaticOrder {
    int nM, nN, nwg, G, c;
    __host__ __device__ void init(int M, int N, int G_, int c_) { nM = M / BM; nN = N / BM; nwg = nM * nN; G = G_; c = c_; }
    __host__ __device__ bool next(int i, Unit& u) const {
        const long L = (long)i * G + c; if (L >= nwg) return false;
        int wgid = (int)L; { const int q = nwg / NXCD, r = nwg % NXCD, xcd = wgid % NXCD, off = wgid / NXCD; wgid = (xcd < r ? xcd * (q + 1) : r * (q + 1) + (xcd - r) * q) + off; }
        const int nig = WGM * nN, gid = wgid / nig, fm = gid * WGM, gsz = (nM - fm) < WGM ? (nM - fm) : WGM;
        u.pm = fm + ((wgid % nig) % gsz); u.pn = (wgid % nig) / gsz; return true;
    }
    __device__ __forceinline__ void a_ready(const Unit&) const {}
    __device__ __forceinline__ void done(const Unit&) const {}
};

__device__ __forceinline__ unsigned cvt_pk_bf16(float lo, float hi) { unsigned r; asm volatile("v_cvt_pk_bf16_f32 %0, %1, %2" : "=v"(r) : "v"(lo), "v"(hi)); return r; }
typedef float f32x2 __attribute__((ext_vector_type(2)));

__device__ __forceinline__ unsigned pkbf(float lo, float hi) { f32x2 v = {lo, hi}; typedef __bf16 bf2 __attribute__((ext_vector_type(2))); bf2 b = __builtin_convertvector(v, bf2); return __builtin_bit_cast(unsigned, b); }
__device__ __forceinline__ u32x4 pack8(const f32x4 a, const f32x4 b) { u32x4 w; w.x = pkbf(a[0], a[1]); w.y = pkbf(a[2], a[3]); w.z = pkbf(b[0], b[1]); w.w = pkbf(b[2], b[3]); return w; }

__device__ __forceinline__ __amdgpu_buffer_rsrc_t mk_rsrc(const void* p) { return __builtin_amdgcn_make_buffer_rsrc((void*)p, 0, 0x7fffffff, 0x00020000); }
__device__ __forceinline__ void st16_wt(__amdgpu_buffer_rsrc_t r, size_t elem_off_bf16, const u32x4 v) { __builtin_amdgcn_raw_buffer_store_b128(v, r, (int)(unsigned)(elem_off_bf16 * 2), 0, 16); }
__device__ __forceinline__ float row_rstd(const float* ssq, int row, int slot0, int ns, float inv_width, int fq) {
    float s = 0.f;
    if (ssq) { if (4 * fq < ns) { const f32x4 v = *(const f32x4*)(ssq + (size_t)row * 16 + slot0 + 4 * fq); s = (v[0] + v[1]) + (v[2] + v[3]); }
        s += __shfl_xor(s, 16); s += __shfl_xor(s, 32); return rsqrtf(s * inv_width + 1e-6f); }
    return 1.f;
}

__device__ __forceinline__ void rows_rstd(float (&rs)[2][4], const float* ssq, int rowbase, int slot0, int ns, float inv_width, int fq) {
    if (!ssq) {
#pragma unroll
        for (int ai = 0; ai < 2; ++ai)
#pragma unroll
            for (int m = 0; m < 4; ++m) rs[ai][m] = 1.f;
        return; }
    f32x4 v[2][4];
#pragma unroll
    for (int ai = 0; ai < 2; ++ai)
#pragma unroll
        for (int m = 0; m < 4; ++m) v[ai][m] = *(const f32x4*)(ssq + (size_t)(rowbase + ai * HALF + m * 16) * 16 + slot0 + (4 * fq < ns ? 4 * fq : 0));
    const float okf = (4 * fq < ns) ? 1.f : 0.f;
#pragma unroll
    for (int ai = 0; ai < 2; ++ai)
#pragma unroll
        for (int m = 0; m < 4; ++m) { float s_ = ((v[ai][m][0] + v[ai][m][1]) + (v[ai][m][2] + v[ai][m][3])) * okf; s_ += __shfl_xor(s_, 16); s_ += __shfl_xor(s_, 32); rs[ai][m] = rsqrtf(s_ * inv_width + 1e-6f); }
}
struct EpiScaleBf16 {
    static constexpr bool PERM = true, AFTER_DRAIN = false;
    bf16_t* O; int ldc; const float* ssq; int slot0, ns; float inv_width; int split_cols; size_t split_stride; int nostore = 0;
    __device__ __forceinline__ void operator()(const f32x4 (&acc)[2][2][4][2], const Unit& u, int wr, int wc, int fr, int fq) const {
        int colt = u.pn * BM; bf16_t* base = O; if (split_cols) { const int t = colt / split_cols; base += (size_t)t * split_stride; colt -= t * split_cols; }
        const int col0 = colt + wc * 32 + 8 * fq;
        float rsv[2][4]; rows_rstd(rsv, ssq, u.pm * BM + wr * 64 + fr, slot0, ns, inv_width, fq);
#pragma unroll
        for (int ai = 0; ai < 2; ++ai)
#pragma unroll
            for (int m = 0; m < 4; ++m) { int row = u.pm * BM + ai * HALF + wr * 64 + m * 16 + fr; asm volatile("" : "+v"(row)); const float rs = rsv[ai][m];
#pragma unroll
                for (int bj = 0; bj < 2; ++bj) { const u32x4 w_ = pack8(acc[ai][bj][m][0] * rs, acc[ai][bj][m][1] * rs); if (nostore) asm volatile("" :: "v"(w_)); else *(u32x4*)(base + (size_t)row * ldc + col0 + bj * HALF) = w_; } }
    }
};
struct EpiNull {
    static constexpr bool PERM = true, AFTER_DRAIN = false;
    __device__ __forceinline__ void operator()(const f32x4 (&acc)[2][2][4][2], const Unit& u, int wr, int wc, int fr, int fq) const {
#pragma unroll
        for (int ai = 0; ai < 2; ++ai)
#pragma unroll
            for (int bj = 0; bj < 2; ++bj)
#pragma unroll
                for (int m = 0; m < 4; ++m) asm volatile("" :: "v"(acc[ai][bj][m][0]), "v"(acc[ai][bj][m][1]));
    }
};
struct EpiResid {
    static constexpr bool PERM = true, AFTER_DRAIN = false;
    bf16_t* xb; float* ssq;
    __device__ __forceinline__ void operator()(const f32x4 (&acc)[2][2][4][2], const Unit& u, int wr, int wc, int fr, int fq) const {
        const int col0 = u.pn * BM + wc * 32 + 8 * fq, rowb = u.pm * BM + wr * 64 + fr;
#pragma unroll
        for (int ai = 0; ai < 2; ++ai) { u32x4 bb[4][2];
#pragma unroll
            for (int m = 0; m < 4; ++m)
#pragma unroll
                for (int bj = 0; bj < 2; ++bj) bb[m][bj] = *(const u32x4*)(xb + (size_t)(rowb + ai * HALF + m * 16) * 1024 + col0 + bj * HALF);
#pragma unroll
            for (int m = 0; m < 4; ++m) { int row = rowb + ai * HALF + m * 16; asm volatile("" : "+v"(row)); float ss = 0.f;
#pragma unroll
                for (int bj = 0; bj < 2; ++bj) { const size_t off = (size_t)row * 1024 + col0 + bj * HALF;
                    const u32x4 b = bb[m][bj];
                    f32x4 v0 = acc[ai][bj][m][0], v1 = acc[ai][bj][m][1];
                    v0[0] += __uint_as_float(b.x << 16); v0[1] += __uint_as_float(b.x & 0xffff0000u); v0[2] += __uint_as_float(b.y << 16); v0[3] += __uint_as_float(b.y & 0xffff0000u);
                    v1[0] += __uint_as_float(b.z << 16); v1[1] += __uint_as_float(b.z & 0xffff0000u); v1[2] += __uint_as_float(b.w << 16); v1[3] += __uint_as_float(b.w & 0xffff0000u);
                    *(u32x4*)(xb + off) = pack8(v0, v1);
                    ss += (v0[0] * v0[0] + v0[1] * v0[1]) + (v0[2] * v0[2] + v0[3] * v0[3]) + (v1[0] * v1[0] + v1[1] * v1[1]) + (v1[2] * v1[2] + v1[3] * v1[3]); }
                ss += __shfl_xor(ss, 16); ss += __shfl_xor(ss, 32);
                if (fq == 0) ssq[(size_t)row * 16 + u.pn * 4 + wc] = ss; } }
    }
};
struct EpiFinal {
    static constexpr bool PERM = true, AFTER_DRAIN = false;
    const bf16_t* xb; float* ssq; float* out; const float* g; unsigned* cnt;
    __device__ __forceinline__ void operator()(f32x4 (&acc)[2][2][4][2], const Unit& u, int wr, int wc, int fr, int fq) const {
        const int col0 = u.pn * BM + wc * 32 + 8 * fq, rowbase = u.pm * BM + wr * 64 + fr;
#pragma unroll
        for (int ai = 0; ai < 2; ++ai)
#pragma unroll
            for (int m = 0; m < 4; ++m) { int row = rowbase + ai * HALF + m * 16; asm volatile("" : "+v"(row)); float ss = 0.f;
#pragma unroll
                for (int bj = 0; bj < 2; ++bj) { const u32x4 b = *(const u32x4*)(xb + (size_t)row * 1024 + col0 + bj * HALF);
                    f32x4& v0 = acc[ai][bj][m][0]; f32x4& v1 = acc[ai][bj][m][1];
                    v0[0] += __uint_as_float(b.x << 16); v0[1] += __uint_as_float(b.x & 0xffff0000u); v0[2] += __uint_as_float(b.y << 16); v0[3] += __uint_as_float(b.y & 0xffff0000u);
                    v1[0] += __uint_as_float(b.z << 16); v1[1] += __uint_as_float(b.z & 0xffff0000u); v1[2] += __uint_as_float(b.w << 16); v1[3] += __uint_as_float(b.w & 0xffff0000u);
                    ss += (v0[0] * v0[0] + v0[1] * v0[1]) + (v0[2] * v0[2] + v0[3] * v0[3]) + (v1[0] * v1[0] + v1[1] * v1[1]) + (v1[2] * v1[2] + v1[3] * v1[3]); }
                ss += __shfl_xor(ss, 16); ss += __shfl_xor(ss, 32);
                if (fq == 0) __hip_atomic_store(ssq + (size_t)row * 16 + u.pn * 4 + wc, ss, __ATOMIC_RELAXED, __HIP_MEMORY_SCOPE_AGENT); }
        asm volatile("s_waitcnt vmcnt(0)" ::: "memory");
        unsigned* c = cnt + 64 * u.pm;
        if ((threadIdx.x & 63) == 0) __hip_atomic_fetch_add(c, 1u, __ATOMIC_RELAXED, __HIP_MEMORY_SCOPE_AGENT);
        { unsigned spins = 0;
          while ((unsigned)__builtin_amdgcn_readfirstlane(__hip_atomic_load(c, __ATOMIC_RELAXED, __HIP_MEMORY_SCOPE_AGENT)) < 32u) { __builtin_amdgcn_s_sleep(2); if (++spins > (1u << 16)) break; } }
        __builtin_amdgcn_fence(__ATOMIC_ACQUIRE, "agent");
        asm volatile("s_waitcnt vmcnt(0)" ::: "memory");
        float rs[2][4]; rows_rstd(rs, ssq, rowbase, 0, 16, 1.f / 1024.f, fq);
        f32x4 gv[2][2];
#pragma unroll
        for (int bj = 0; bj < 2; ++bj) { gv[bj][0] = *(const f32x4*)(g + col0 + bj * HALF); gv[bj][1] = *(const f32x4*)(g + col0 + bj * HALF + 4); }
#pragma unroll
        for (int ai = 0; ai < 2; ++ai)
#pragma unroll
            for (int m = 0; m < 4; ++m) { int row = rowbase + ai * HALF + m * 16; asm volatile("" : "+v"(row));
#pragma unroll
                for (int bj = 0; bj < 2; ++bj) { float* op = out + (size_t)row * 1024 + col0 + bj * HALF;
                    *(f32x4*)(op) = acc[ai][bj][m][0] * rs[ai][m] * gv[bj][0]; *(f32x4*)(op + 4) = acc[ai][bj][m][1] * rs[ai][m] * gv[bj][1]; } }
    }
};
__device__ __forceinline__ float silu_mul(float g, float u) { return (g * u) * __builtin_amdgcn_rcpf(1.f + __builtin_amdgcn_exp2f(g * -1.4426950408889634f)); }
struct EpiSwiglu {
    static constexpr bool PERM = true, AFTER_DRAIN = false;
    bf16_t* H; const float* ssq;
    __device__ __forceinline__ void operator()(const f32x4 (&acc)[2][2][4][2], const Unit& u, int wr, int wc, int fr, int fq) const {
        const int col0 = u.pn * HALF + wc * 32 + 8 * fq;
        float rsv[2][4]; rows_rstd(rsv, ssq, u.pm * BM + wr * 64 + fr, 0, 16, 1.f / 1024.f, fq);
#pragma unroll
        for (int ai = 0; ai < 2; ++ai)
#pragma unroll
            for (int m = 0; m < 4; ++m) { int row = u.pm * BM + ai * HALF + wr * 64 + m * 16 + fr; asm volatile("" : "+v"(row)); const float rs = rsv[ai][m];
                f32x4 h0, h1;
#pragma unroll
                for (int e = 0; e < 4; ++e) { h0[e] = silu_mul(acc[ai][0][m][0][e] * rs, acc[ai][1][m][0][e] * rs); h1[e] = silu_mul(acc[ai][0][m][1][e] * rs, acc[ai][1][m][1][e] * rs); }
                *(u32x4*)(H + (size_t)row * 2816 + col0) = pack8(h0, h1); }
    }
};
struct EpiZ1 {
    static constexpr bool PERM = true, AFTER_DRAIN = false;
    bf16_t* Z1; const float* ssq; float* ssq2; float* gates; const float* gate_bias;
    __device__ __forceinline__ void operator()(const f32x4 (&acc)[2][2][4][2], const Unit& u, int wr, int wc, int fr, int fq) const {
        const int col0 = u.pn * BM + wc * 32 + 8 * fq;
float rsv[2][4]; rows_rstd(rsv, ssq, u.pm * BM + wr * 64 + fr, 0, 16, 1.f / 1024.f, fq);
        const f32x4 gb0 = *(const f32x4*)(gate_bias), gb1 = *(const f32x4*)(gate_bias + 4);

#pragma unroll
        for (int ai = 0; ai < 2; ++ai)
#pragma unroll
            for (int m = 0; m < 4; ++m) { int row = u.pm * BM + ai * HALF + wr * 64 + m * 16 + fr; asm volatile("" : "+v"(row)); const float rs = rsv[ai][m];
                float sq[2];
#pragma unroll
                for (int bj = 0; bj < 2; ++bj) { const f32x4 v0 = acc[ai][bj][m][0] * rs, v1 = acc[ai][bj][m][1] * rs;
                    *(u32x4*)(Z1 + (size_t)row * 2816 + col0 + bj * HALF) = pack8(v0, v1);
                    sq[bj] = (v0[0] * v0[0] + v0[1] * v0[1]) + (v0[2] * v0[2] + v0[3] * v0[3]) + (v1[0] * v1[0] + v1[1] * v1[1]) + (v1[2] * v1[2] + v1[3] * v1[3]); }
                if (u.pn >= 8) { float s = (u.pn == 9) ? sq[0] : sq[0] + sq[1]; s += __shfl_xor(s, 16); s += __shfl_xor(s, 32);
                    if (fq == 0) ssq2[(size_t)row * 16 + (u.pn == 10 ? 8 : (u.pn - 8) * 4) + wc] = s; }
                if (u.pn == 9 && wc == 1 && fq == 0) { const f32x4 gi = acc[ai][1][m][0] * rs + gb0, gf = acc[ai][1][m][1] * rs + gb1;
                    *(f32x4*)(gates + (size_t)row * 8) = gi; *(f32x4*)(gates + (size_t)row * 8 + 4) = gf; } }
    }
};
struct RopeTab { f32x4 c0, c1, s0, s1; };
__device__ __forceinline__ RopeTab rope_load(const float* rope, int row, int fq) { const float* rp = rope + (size_t)row * 32 + 8 * (fq & 1);
    RopeTab t; t.c0 = *(const f32x4*)(rp); t.c1 = *(const f32x4*)(rp + 4); t.s0 = *(const f32x4*)(rp + 16); t.s1 = *(const f32x4*)(rp + 20); return t; }
__device__ __forceinline__ void rope8(f32x4& v0, f32x4& v1, const RopeTab& t, int fq) {
    f32x4 o0, o1;
#pragma unroll
    for (int e = 0; e < 4; ++e) { auto r0 = __builtin_amdgcn_permlane32_swap(__float_as_uint(v0[e]), __float_as_uint(v0[e]), false, false); o0[e] = __uint_as_float(fq < 2 ? r0[1] : r0[0]);
        auto r1 = __builtin_amdgcn_permlane32_swap(__float_as_uint(v1[e]), __float_as_uint(v1[e]), false, false); o1[e] = __uint_as_float(fq < 2 ? r1[1] : r1[0]); }
    if (fq < 2) { v0 = v0 * t.c0 - o0 * t.s0; v1 = v1 * t.c1 - o1 * t.s1; } else { v0 = o0 * t.s0 + v0 * t.c0; v1 = o1 * t.s1 + v1 * t.c1; }
}
struct EpiMlaQ {
    static constexpr bool PERM = true, AFTER_DRAIN = false;
    bf16_t* QM; const float* ssq2; const float* rope;
    __device__ __forceinline__ void operator()(const f32x4 (&acc)[2][2][4][2], const Unit& u, int wr, int wc, int fr, int fq) const {
        const int col0 = u.pn * BM + wc * 32 + 8 * fq, rowb = u.pm * BM + wr * 64 + fr;
        float rsv[2][4]; rows_rstd(rsv, ssq2, rowb, 0, 8, 1.f / 384.f, fq);
        const bool rg0 = (u.pn * 8 + wc) % 3 == 2, rg1 = (u.pn * 8 + 4 + wc) % 3 == 2;
#pragma unroll
        for (int am = 0; am < 4; ++am) { const int ai = am >> 1; RopeTab tb[2];
            if (rg0 || rg1) {
#pragma unroll
                for (int m2 = 0; m2 < 2; ++m2) tb[m2] = rope_load(rope, rowb + ai * HALF + ((am & 1) * 2 + m2) * 16, fq); }
#pragma unroll
            for (int m2 = 0; m2 < 2; ++m2) { const int m = (am & 1) * 2 + m2; int row = rowb + ai * HALF + m * 16; asm volatile("" : "+v"(row)); const float rs = rsv[ai][m];
#pragma unroll
                for (int bj = 0; bj < 2; ++bj) { f32x4 v0 = acc[ai][bj][m][0] * rs, v1 = acc[ai][bj][m][1] * rs;
                    if (bj == 0 ? rg0 : rg1) rope8(v0, v1, tb[m2], fq);
                    *(u32x4*)(QM + (size_t)row * 768 + col0 + bj * HALF) = pack8(v0, v1); } } }
    }
};
struct EpiMlaKV {
    static constexpr bool PERM = true, AFTER_DRAIN = false;
    bf16_t* KM; bf16_t* VM; const bf16_t* Z1; const float* ssq2; const float* rope;
    __device__ __forceinline__ void operator()(const f32x4 (&acc)[2][2][4][2], const Unit& u, int wr, int wc, int fr, int fq) const {
        const int rowb = u.pm * BM + wr * 64 + fr;
        float rsv[2][4]; rows_rstd(rsv, ssq2, rowb, 8, 4, 1.f / 256.f, fq);
#pragma unroll
        for (int am = 0; am < 4; ++am) { const int ai = am >> 1; RopeTab tb[2]; u32x4 raw[2];
            if (wc == 0) {
#pragma unroll
                for (int m2 = 0; m2 < 2; ++m2) { const int r_ = rowb + ai * HALF + ((am & 1) * 2 + m2) * 16; tb[m2] = rope_load(rope, r_, fq); raw[m2] = *(const u32x4*)(Z1 + (size_t)r_ * 2816 + 2432 + 8 * fq); } }
#pragma unroll
            for (int m2 = 0; m2 < 2; ++m2) { const int m = (am & 1) * 2 + m2; int row = rowb + ai * HALF + m * 16; asm volatile("" : "+v"(row)); const float rs = rsv[ai][m];
#pragma unroll
                for (int bj = 0; bj < 2; ++bj) { const int h = 2 * u.pn + bj; const u32x4 w = pack8(acc[ai][bj][m][0] * rs, acc[ai][bj][m][1] * rs);
                    if (wc < 2) *(u32x4*)(KM + (size_t)row * 768 + h * 96 + wc * 32 + 8 * fq) = w; else *(u32x4*)(VM + (size_t)row * 512 + h * 64 + (wc - 2) * 32 + 8 * fq) = w; }
                if (wc == 0) { f32x4 v0, v1; const u32x4 r_ = raw[m2];
                    v0[0] = __uint_as_float(r_.x << 16); v0[1] = __uint_as_float(r_.x & 0xffff0000u); v0[2] = __uint_as_float(r_.y << 16); v0[3] = __uint_as_float(r_.y & 0xffff0000u);
                    v1[0] = __uint_as_float(r_.z << 16); v1[1] = __uint_as_float(r_.z & 0xffff0000u); v1[2] = __uint_as_float(r_.w << 16); v1[3] = __uint_as_float(r_.w & 0xffff0000u);
                    rope8(v0, v1, tb[m2], fq); const u32x4 w = pack8(v0, v1);
#pragma unroll
                    for (int bj = 0; bj < 2; ++bj) *(u32x4*)(KM + (size_t)row * 768 + (2 * u.pn + bj) * 96 + 64 + 8 * fq) = w; } } }
    }
};

template <class Epi, class Sched, bool ALIGN_EPI = false, bool SP2 = false>
__device__ __forceinline__ void gemm_phase(PG8_LAS unsigned char* lds, const Gemm g, const Sched& S, const Epi& E) {
    int tid_ = threadIdx.x; asm volatile("" : "+v"(tid_));
    const int tid = tid_, wid = __builtin_amdgcn_readfirstlane(tid >> 6), lane = tid & 63, wr = wid >> 2, wc = wid & 3, fr = lane & 15, fq = lane >> 4;
    int K_ = g.K; asm volatile("" : "+s"(K_));
    const int K = K_, nt = K / BK;
    unsigned voffA[2], voffB[2];
#pragma unroll
    for (int i = 0; i < 2; ++i) { int R, C; stage_rc(tid * 16 + i * 8192, R, C); const int Rb = Epi::PERM ? ((R & ~31) + perm32(R & 31)) : R;
        voffA[i] = (unsigned)(R * g.lda + C) * 2u; voffB[i] = (unsigned)(Rb * K + C) * 2u; }
    const size_t kstep = (size_t)(BK * 2);
    const size_t hstep = (size_t)HALF * K * 2;
    const size_t tstep = 2 * hstep;
    const size_t hstepA = (size_t)HALF * g.lda * 2, tstepA = 2 * hstepA;
    const unsigned ldsw = (unsigned)wid * 1024u;
    const int aoff = lds_byte(wr * 64 + fr, fq * 8), boff = lds_byte(wc * 32 + fr, fq * 8);
#define PG8_SA(b, h) (((b) * 2 + (h)) * HTB)
#define PG8_SB(b, h) ((4 + (b) * 2 + (h)) * HTB)
#define PG8_STAGE(bufoff, gbase, voff) do { _Pragma("unroll") for (int _i = 0; _i < 2; ++_i) \
        __builtin_amdgcn_global_load_lds((const unsigned*)((const char*)(gbase) + (voff)[_i]), (PG8_LAS unsigned*)(lds + (bufoff) + ldsw + _i * 8192), 16, 0, 0); } while (0)
#define PG8_LDA(dst, b, h) do { _Pragma("unroll") for (int m = 0; m < 4; ++m) _Pragma("unroll") for (int k = 0; k < 2; ++k) dst[m][k] = *(const PG8_LAS bf16x8*)(lds + PG8_SA(b, h) + aoff + m * 2048 + k * 1024); } while (0)
#define PG8_LDB(dst, b, h) do { _Pragma("unroll") for (int n = 0; n < 2; ++n) _Pragma("unroll") for (int k = 0; k < 2; ++k) dst[n][k] = *(const PG8_LAS bf16x8*)(lds + PG8_SB(b, h) + boff + n * 2048 + k * 1024); } while (0)
#define PG8_MMA(ai, bj, At, Bt) do { __builtin_amdgcn_s_setprio(1); _Pragma("unroll") for (int m = 0; m < 4; ++m) _Pragma("unroll") for (int n = 0; n < 2; ++n) _Pragma("unroll") for (int k = 0; k < 2; ++k) \
        acc[ai][bj][m][n] = __builtin_amdgcn_mfma_f32_16x16x32_bf16(Bt[n][k], At[m][k], acc[ai][bj][m][n], 0, 0, 0); __builtin_amdgcn_s_setprio(0); } while (0)
#define PG8_WAIT_V(n) asm volatile("s_waitcnt vmcnt(" #n ")" ::: "memory")
#define PG8_WAIT_L(n) asm volatile("s_waitcnt lgkmcnt(" #n ")" ::: "memory")
#define PG8_BAR __builtin_amdgcn_s_barrier()
#define PG8_SCHED __builtin_amdgcn_sched_barrier(0)
    Unit cur, nxt; int ui = 0;
    if (!S.next(0, cur)) return;
    f32x4 acc[2][2][4][2];
#pragma unroll
    for (int a = 0; a < 2; ++a)
#pragma unroll
        for (int b = 0; b < 2; ++b)
#pragma unroll
            for (int m = 0; m < 4; ++m)
#pragma unroll
                for (int n = 0; n < 2; ++n) acc[a][b][m][n] = (f32x4){0.f, 0.f, 0.f, 0.f};
    bf16x8 At[4][2], B0[2][2], B1[2][2];
    const char* cA = (const char*)g.A + (size_t)cur.pm * tstepA; const char* cB = (const char*)g.Bt + (size_t)cur.pn * tstep;
    S.a_ready(cur);
    if constexpr (SP2) {
        PG8_STAGE(PG8_SB(0, 0), cB, voffB); PG8_STAGE(PG8_SB(0, 1), cB + hstep, voffB); PG8_STAGE(PG8_SA(0, 0), cA, voffA); PG8_STAGE(PG8_SA(0, 1), cA + hstepA, voffA);
        if (wr == 1) PG8_BAR;
        PG8_WAIT_V(2); PG8_BAR;
        PG8_STAGE(PG8_SB(1, 0), cB + kstep, voffB); PG8_STAGE(PG8_SA(1, 0), cA + kstep, voffA); PG8_STAGE(PG8_SB(1, 1), cB + hstep + kstep, voffB);
        PG8_WAIT_V(6); PG8_BAR;
    } else {
        PG8_STAGE(PG8_SB(0, 0), cB, voffB); PG8_STAGE(PG8_SA(0, 0), cA, voffA); PG8_STAGE(PG8_SB(0, 1), cB + hstep, voffB); PG8_STAGE(PG8_SA(0, 1), cA + hstepA, voffA);
        if (wr == 1) PG8_BAR;
        PG8_WAIT_V(4); PG8_BAR;
        PG8_STAGE(PG8_SB(1, 0), cB + kstep, voffB); PG8_STAGE(PG8_SA(1, 0), cA + kstep, voffA); PG8_STAGE(PG8_SB(1, 1), cB + hstep + kstep, voffB);
        PG8_WAIT_V(6); PG8_BAR;
    }
    for (;;) {
        const bool has_next = S.next(ui + 1, nxt);
        const char* nA = has_next ? (const char*)g.A + (size_t)nxt.pm * tstepA : cA; const char* nB = has_next ? (const char*)g.Bt + (size_t)nxt.pn * tstep : cB;
        for (int t = 0; t < nt; t += 2) {
            const bool last = (t == nt - 2);
            const char* a1 = cA + (size_t)(t + 1) * kstep;
            const char* a2 = last ? nA : cA + (size_t)(t + 2) * kstep; const char* b2 = last ? nB : cB + (size_t)(t + 2) * kstep;
            const char* a3 = a2 + kstep; const char* b3 = b2 + kstep;
            if (last && has_next) S.a_ready(nxt);
            if constexpr (SP2) {
            PG8_LDB(B0, 0, 0); PG8_LDB(B1, 0, 1); PG8_SCHED; PG8_LDA(At, 0, 0); PG8_STAGE(PG8_SA(1, 1), a1 + hstepA, voffA);
            PG8_WAIT_V(8); PG8_WAIT_L(0); PG8_BAR; PG8_MMA(0, 0, At, B0); PG8_MMA(0, 1, At, B1); PG8_BAR; PG8_SCHED;
            PG8_LDA(At, 0, 1); PG8_STAGE(PG8_SB(0, 0), b2, voffB); PG8_STAGE(PG8_SB(0, 1), b2 + hstep, voffB); PG8_STAGE(PG8_SA(0, 0), a2, voffA);
            PG8_WAIT_V(8); PG8_WAIT_L(0); PG8_BAR; PG8_MMA(1, 0, At, B0); PG8_MMA(1, 1, At, B1); PG8_BAR; PG8_SCHED;
            PG8_LDB(B0, 1, 0); PG8_LDB(B1, 1, 1); PG8_SCHED; PG8_LDA(At, 1, 0); PG8_STAGE(PG8_SA(0, 1), a2 + hstepA, voffA);
            PG8_WAIT_V(8); PG8_WAIT_L(0); PG8_BAR; PG8_MMA(0, 0, At, B0); PG8_MMA(0, 1, At, B1); PG8_BAR; PG8_SCHED;
            PG8_LDA(At, 1, 1); PG8_STAGE(PG8_SB(1, 0), b3, voffB); PG8_STAGE(PG8_SB(1, 1), b3 + hstep, voffB); PG8_STAGE(PG8_SA(1, 0), a3, voffA);
            PG8_WAIT_V(8); PG8_WAIT_L(0); PG8_BAR; PG8_MMA(1, 0, At, B0); PG8_MMA(1, 1, At, B1); PG8_BAR; PG8_SCHED;
            } else {
            PG8_LDB(B0, 0, 0); PG8_SCHED; PG8_LDA(At, 0, 0); PG8_STAGE(PG8_SA(1, 1), a1 + hstepA, voffA);
            PG8_WAIT_L(8); PG8_BAR; PG8_WAIT_L(0); PG8_MMA(0, 0, At, B0); PG8_BAR; PG8_SCHED;
            PG8_LDB(B1, 0, 1); PG8_STAGE(PG8_SB(0, 0), b2, voffB);
            PG8_BAR; PG8_WAIT_L(0); PG8_MMA(0, 1, At, B1); PG8_BAR;
            PG8_LDA(At, 0, 1); PG8_STAGE(PG8_SA(0, 0), a2, voffA);
            PG8_BAR; PG8_WAIT_L(0); PG8_MMA(1, 0, At, B0); PG8_BAR; PG8_SCHED;
            PG8_STAGE(PG8_SB(0, 1), b2 + hstep, voffB);
            PG8_WAIT_V(6); PG8_BAR; PG8_MMA(1, 1, At, B1); PG8_BAR;
            PG8_LDB(B0, 1, 0); PG8_SCHED; PG8_LDA(At, 1, 0); PG8_STAGE(PG8_SA(0, 1), a2 + hstepA, voffA);
            PG8_WAIT_L(8); PG8_BAR; PG8_WAIT_L(0); PG8_MMA(0, 0, At, B0); PG8_BAR; PG8_SCHED;
            PG8_LDB(B1, 1, 1); PG8_STAGE(PG8_SB(1, 0), b3, voffB);
            PG8_BAR; PG8_WAIT_L(0); PG8_MMA(0, 1, At, B1); PG8_BAR;
            PG8_LDA(At, 1, 1); PG8_STAGE(PG8_SA(1, 0), a3, voffA);
            PG8_BAR; PG8_WAIT_L(0); PG8_MMA(1, 0, At, B0); PG8_BAR; PG8_SCHED;
            PG8_STAGE(PG8_SB(1, 1), b3 + hstep, voffB);
            PG8_WAIT_V(6); PG8_BAR; PG8_MMA(1, 1, At, B1); PG8_BAR;
            }
        }
        if constexpr (ALIGN_EPI) { if (wr == 0) PG8_BAR; }
        if constexpr (!Epi::AFTER_DRAIN) { E(acc, cur, wr, wc, fr, fq); S.done(cur); }
        if (!has_next) break;
#pragma unroll
        for (int a = 0; a < 2; ++a)
#pragma unroll
            for (int b = 0; b < 2; ++b)
#pragma unroll
                for (int m = 0; m < 4; ++m)
#pragma unroll
                    for (int n = 0; n < 2; ++n) acc[a][b][m][n] = (f32x4){0.f, 0.f, 0.f, 0.f};
        cur = nxt; cA = nA; cB = nB; ++ui;
        if constexpr (ALIGN_EPI) { if (wr == 1) PG8_BAR; }
    }
    PG8_WAIT_V(0);
    if constexpr (!ALIGN_EPI) { if (wr == 0) PG8_BAR; }
    PG8_BAR;
    if constexpr (Epi::AFTER_DRAIN) { E.fused(acc, cur, wr, wc, fr, fq, lds, wid, lane); S.done(cur); }
#undef PG8_SA
#undef PG8_SB
#undef PG8_STAGE
#undef PG8_LDA
#undef PG8_LDB
#undef PG8_MMA
#undef PG8_WAIT_V
#undef PG8_WAIT_L
#undef PG8_BAR
#undef PG8_SCHED
}
}
#define GAS __attribute__((address_space(1)))
#define LAS __attribute__((address_space(3)))
typedef unsigned short bf16;
typedef unsigned v4u __attribute__((ext_vector_type(4)));
typedef float f32x4 __attribute__((ext_vector_type(4)));
typedef short bf16x8 __attribute__((ext_vector_type(8)));
typedef GAS unsigned gu32;
typedef GAS unsigned long long gu64;
#define RLX_AGENT __ATOMIC_RELAXED, __HIP_MEMORY_SCOPE_AGENT
#define LDS_WAIT() asm volatile("s_waitcnt lgkmcnt(0)" ::: "memory")
#define VM_WAIT() asm volatile("s_waitcnt vmcnt(0)" ::: "memory")
__device__ __forceinline__ unsigned long long rt() { return __builtin_amdgcn_s_memrealtime(); }
__device__ __forceinline__ unsigned f2bf(float f) { unsigned u = __builtin_bit_cast(unsigned, f); return (u + 0x7fffu + ((u >> 16) & 1u)) >> 16; }
__device__ __forceinline__ unsigned pk2(float lo, float hi) { return f2bf(lo) | (f2bf(hi) << 16); }

#define XB_TMO      128
#define XB_XCNT(j)  (256  + 64 * (j))
#define XB_XSUB(j)  (1280 + 64 * (j))
#define XB_XGEN(j)  (2304 + 64 * (j))
#define XB_TOP      3328
#define XB_TOPGEN   3392
#define XCD_BAR_WORDS 3456
#define XB_SPIN_CAP (1u << 18)

__device__ __forceinline__ unsigned xb_ld(unsigned* p)              { return __hip_atomic_load(p, __ATOMIC_RELAXED, __HIP_MEMORY_SCOPE_AGENT); }
__device__ __forceinline__ unsigned xb_add(unsigned* p, unsigned v) { return __hip_atomic_fetch_add(p, v, __ATOMIC_RELAXED, __HIP_MEMORY_SCOPE_AGENT); }
__device__ __forceinline__ unsigned xb_xcc_id() { return (unsigned)__builtin_amdgcn_s_getreg((3 << 11) | 20) & 0xFu; }
#define XB_SPIN(cond, bar) do { unsigned _sp = 0; while (cond) { __builtin_amdgcn_s_sleep(1); \
    if ((++_sp & 255u) == 0u) { if (xb_ld(&(bar)[XB_TMO])) break; if (_sp > XB_SPIN_CAP) { atomicAdd(&(bar)[XB_TMO], 1u); break; } } } } while (0)

struct XcdBarrier {
    unsigned* bar; unsigned x;
    volatile LAS unsigned* st;
};

__device__ __forceinline__ XcdBarrier xcd_barrier_post(unsigned* bar, volatile LAS unsigned* st) {
    XcdBarrier b; b.bar = bar; b.x = xb_xcc_id(); b.st = st;
    if (threadIdx.x == 0) (void)xb_add(&bar[XB_XCNT(b.x)], 1u);
    return b;
}
__device__ __forceinline__ void xcd_barrier_complete(unsigned* bar, unsigned x, unsigned& nloc, unsigned& nx) {
    const unsigned G = gridDim.x * gridDim.y * gridDim.z;
    unsigned sum, cnt, mine, sp = 0u;
    for (;;) {
        sum = 0u; cnt = 0u; mine = 0u;
#pragma unroll
        for (unsigned j = 0; j < 16; ++j) { const unsigned c = xb_ld(&bar[XB_XCNT(j)]); sum += c; cnt += (c > 0u) ? 1u : 0u; mine = (j == x) ? c : mine; }
        if (sum == G) break;
        __builtin_amdgcn_s_sleep(1);
        if ((++sp & 255u) == 0u) { if (xb_ld(&bar[XB_TMO])) break; if (sp > XB_SPIN_CAP) { atomicAdd(&bar[XB_TMO], 1u); break; } }
    }
    nloc = mine > 0u ? mine : 1u; nx = cnt > 0u ? cnt : 1u;
}

__device__ __forceinline__ void xcd_barrier(const XcdBarrier& b) {
    asm volatile("s_waitcnt vmcnt(0)" ::: "memory");
    __syncthreads();
    if (threadIdx.x == 0) {
        unsigned* bar = b.bar;
        __builtin_amdgcn_s_waitcnt(0);
        unsigned nloc = b.st[0], nx = b.st[1];
        if (nloc == 0u) { xcd_barrier_complete(bar, b.x, nloc, nx); b.st[0] = nloc; b.st[1] = nx; }
        const unsigned old = xb_add(&bar[XB_XSUB(b.x)], 1u);
        const unsigned gen = old / nloc;
        if (old + 1u == (gen + 1u) * nloc) {
            __builtin_amdgcn_fence(__ATOMIC_RELEASE, "agent");
            asm volatile("s_waitcnt vmcnt(0)" ::: "memory");
            const unsigned og = xb_add(&bar[XB_TOP], 1u);
            const unsigned tg = og / nx;
            if (og + 1u == (tg + 1u) * nx) xb_add(&bar[XB_TOPGEN], 1u);
            else XB_SPIN(xb_ld(&bar[XB_TOPGEN]) == tg, bar);
            __builtin_amdgcn_fence(__ATOMIC_ACQUIRE, "agent");
            xb_add(&bar[XB_XGEN(b.x)], 1u);
            asm volatile("s_waitcnt vmcnt(0)" ::: "memory");
        } else {
            XB_SPIN(xb_ld(&bar[XB_XGEN(b.x)]) == gen, bar);
            __builtin_amdgcn_fence(__ATOMIC_ACQUIRE, "agent");
            asm volatile("s_waitcnt vmcnt(0)" ::: "memory");
        }
    }
    __syncthreads();
}
constexpr int NWAVES = 8;
constexpr int RING_OFF = 0, RING_BYTES = 139264;
constexpr int LDSCTL_OFF = RING_BYTES, MISC_OFF = LDSCTL_OFF + 320;
constexpr int LDS_BYTES = 147456;
constexpr int CW_FIN = 4096 + 2 * 3456;
constexpr int CW_BAR = 4096;
constexpr size_t WS_SSQ2 = 2 * MiB;
constexpr size_t WS_ROPE = 254 * MiB;
constexpr size_t WB_EVIN = 0, WB_EVOUT = WB_EVIN + 2048 * 1024, WB_POOL = WB_EVOUT + 1024 * 1024, WB_Q0 = WB_POOL + 4 * 128 * 128, WB_O0 = WB_Q0 + 512 * 1024,
                 WB_GU0 = WB_O0 + 1024 * 512, WB_DN0 = WB_GU0 + 5632 * 1024, WB_ODIN = WB_DN0 + 1024 * 2816, WB_UQ = WB_ODIN + 2816 * 1024, WB_UKV = WB_UQ + 768 * 384,
                 WB_ODOUT = WB_UKV + 1024 * 256, WB_Q1 = WB_ODOUT + 1024 * 1024, WB_O1 = WB_Q1 + 512 * 1024, WB_GU1 = WB_O1 + 1024 * 512, WB_DN1 = WB_GU1 + 5632 * 1024,
                 WB_KV = WB_DN1 + 1024 * 2816, WB_ENDE = WB_KV + 2048 * 1024;
static_assert(WB_ENDE * 2 <= 60 * MiB, "bf16 weights fit their region");
constexpr int NMATS = 20;
struct Mat { const float* W; const float* gain; bf16_t* dst; int ldw, K, Ndst, map; };
struct Args { const float* in[26]; float* out; unsigned char* ws; Mat mats[NMATS]; int ph_lo, ph_hi, li, pad; };

struct Frame {
    LAS unsigned char* lds; volatile LAS unsigned* MISC; gu32* ctl;
    int tid, lane, wave, vcu, G;
};
__device__ __forceinline__ float wave_sum(float v) {
#pragma unroll
    for (int o = 1; o < 64; o <<= 1) v += __shfl_xor(v, o);
    return v;
}
__device__ __forceinline__ int src_col(int map, int r0, int& valid) {
    valid = 32;
    if (map == 0) return r0;
    if (map == 1) { const int tile = r0 >> 8, w = r0 & 255; return (w < 128) ? 128 * tile + w : 2816 + 128 * tile + (w - 128); }
    if (r0 < 2048) return r0;
    if (r0 < 2432) return 2056 + (r0 - 2048);
    if (r0 == 2432) return 2696;
    if (r0 == 2464) { valid = 8; return 2048; }
    if (r0 < 2560) { valid = 0; return 0; }
    return 2440 + (r0 - 2560);
}
__device__ __forceinline__ void p0_transpose_item(const Mat& mt, LAS float* scr, int item, int lane) {
    const int nblk = mt.Ndst / 64, kb = item / nblk, nb = item % nblk, k0 = 64 * kb, n0 = 64 * nb;
    const int cq = lane & 15, kr = lane >> 4, hf = cq >> 3;
    int valid; const int sc = src_col(mt.map, n0 + 32 * hf, valid);
    const bool ok = 4 * (cq & 7) < valid;
    const float* src = mt.W + (size_t)(k0 + kr) * mt.ldw + (ok ? sc + 4 * (cq & 7) : 0);
    f32x4 v[16]; float gn[16]; const float okf = ok ? 1.f : 0.f;
    if (mt.gain) {
#pragma unroll
        for (int i = 0; i < 16; ++i) gn[i] = mt.gain[k0 + kr + 4 * i];
    } else {
#pragma unroll
        for (int i = 0; i < 16; ++i) gn[i] = 1.f; }
#pragma unroll
    for (int i = 0; i < 16; ++i) v[i] = *(const GAS f32x4*)(src + (size_t)(4 * i) * mt.ldw);
#pragma unroll
    for (int i = 0; i < 16; ++i) v[i] = v[i] * (gn[i] * okf);
#pragma unroll
    for (int i = 0; i < 16; ++i) { LAS float* d = scr + (kr + 4 * i) * 65 + 4 * cq; d[0] = v[i].x; d[1] = v[i].y; d[2] = v[i].z; d[3] = v[i].w; }
    LDS_WAIT(); asm volatile("" ::: "memory");
    const int c = lane & 7;
#pragma unroll
    for (int j = 0; j < 8; ++j) { const int n = (lane >> 3) + 8 * j; const LAS float* s_ = scr + (8 * c) * 65 + n;
        v4u o; o.x = pk2(s_[0 * 65], s_[1 * 65]); o.y = pk2(s_[2 * 65], s_[3 * 65]); o.z = pk2(s_[4 * 65], s_[5 * 65]); o.w = pk2(s_[6 * 65], s_[7 * 65]);
        *(GAS v4u*)(mt.dst + (size_t)(n0 + n) * mt.K + k0 + 8 * c) = o; }
    LDS_WAIT(); asm volatile("" ::: "memory");
}
__device__ __forceinline__ float row_to_bf16(const float* xrow, bf16_t* orow, bool normalize, int lane) {
    const GAS f32x4* xr = (const GAS f32x4*)xrow + lane;
    f32x4 v[4]; float s = 0.f;
#pragma unroll
    for (int j = 0; j < 4; ++j) { v[j] = xr[64 * j]; s += (v[j].x * v[j].x + v[j].y * v[j].y) + (v[j].z * v[j].z + v[j].w * v[j].w); }
    s = wave_sum(s);
    const float sc = normalize ? rsqrtf(s * (1.f / 1024.f) + 1e-6f) : 1.f;
    GAS unsigned long long* o8 = (GAS unsigned long long*)orow + lane;
#pragma unroll
    for (int j = 0; j < 4; ++j) o8[64 * j] = (unsigned long long)pk2(v[j].x * sc, v[j].y * sc) | ((unsigned long long)pk2(v[j].z * sc, v[j].w * sc) << 32);
    return s;
}
constexpr int NMATS_MID = 18;
constexpr int NMATS_EARLY = 11;
__device__ __forceinline__ void p0_convert(const Args& args, LAS float* scr, int m_lo, int m_hi, int gw, int NGW, int lane) {
    int base = 0;
    for (int mi = m_lo; mi < m_hi; ++mi) {
        const Mat mt = args.mats[mi]; const int nit = (mt.K / 64) * (mt.Ndst / 64);
        int first = (gw - (base % NGW) + NGW) % NGW;
        for (int it = first; it < nit; it += NGW) p0_transpose_item(mt, scr, it, lane);
        base += nit;
    }
}
__device__ __forceinline__ void p0_prologue(Frame& F, const Args& args) {
    int tid_ = threadIdx.x; asm volatile("" : "+v"(tid_)); const int lane_ = tid_ & 63, wave_ = __builtin_amdgcn_readfirstlane(tid_ >> 6);
    LAS float* scr = (LAS float*)(F.lds + RING_OFF + wave_ * 16640);
    const int gw = F.vcu * NWAVES + wave_, NGW = F.G * NWAVES;
    p0_convert(args, scr, 0, NMATS_EARLY, gw, NGW, lane_);
    unsigned char* ws = args.ws;
    bf16_t* XB = (bf16_t*)(ws + WS_XB); float* SSQ = (float*)(ws + WS_SSQ); bf16_t* MEMN = (bf16_t*)(ws + WS_MEMN); float* ROPE = (float*)(ws + WS_ROPE);
    const float* x = args.in[0]; const float* mem = args.in[1]; const int* pos = (const int*)args.in[2];
    for (int m = gw; m < MTOK; m += 2 * NGW) {
        const int m2 = m + NGW; const GAS f32x4* xa = (const GAS f32x4*)(x + (size_t)m * DM) + lane_; const GAS f32x4* xb2 = (const GAS f32x4*)(x + (size_t)(m2 < MTOK ? m2 : m) * DM) + lane_;
        f32x4 va[4], vb[4]; float sa = 0.f, sb = 0.f;
#pragma unroll
        for (int j = 0; j < 4; ++j) { va[j] = xa[64 * j]; vb[j] = xb2[64 * j]; }
#pragma unroll
        for (int j = 0; j < 4; ++j) { sa += (va[j].x * va[j].x + va[j].y * va[j].y) + (va[j].z * va[j].z + va[j].w * va[j].w); sb += (vb[j].x * vb[j].x + vb[j].y * vb[j].y) + (vb[j].z * vb[j].z + vb[j].w * vb[j].w); }
        sa = wave_sum(sa); sb = wave_sum(sb);
        GAS unsigned long long* oa = (GAS unsigned long long*)(XB + (size_t)m * DM) + lane_;
#pragma unroll
        for (int j = 0; j < 4; ++j) oa[64 * j] = (unsigned long long)pk2(va[j].x, va[j].y) | ((unsigned long long)pk2(va[j].z, va[j].w) << 32);
        if (lane_ < 16) SSQ[(size_t)m * 16 + lane_] = (lane_ == 0) ? sa : 0.f;
        if (m2 < MTOK) { GAS unsigned long long* ob = (GAS unsigned long long*)(XB + (size_t)m2 * DM) + lane_;
#pragma unroll
            for (int j = 0; j < 4; ++j) ob[64 * j] = (unsigned long long)pk2(vb[j].x, vb[j].y) | ((unsigned long long)pk2(vb[j].z, vb[j].w) << 32);
            if (lane_ < 16) SSQ[(size_t)m2 * 16 + lane_] = (lane_ == 0) ? sb : 0.f; }
    }
    for (int m = gw; m < BATCH * NMEM; m += NGW) (void)row_to_bf16(mem + (size_t)m * DM, MEMN + (size_t)m * DM, true, lane_);
    for (int i = gw * 64 + lane_; i < MTOK * 16; i += NGW * 64) { const int row = i >> 4, k = i & 15;
        const float ang = (float)pos[row] * powf(10000.0f, -(float)k / 16.0f); ROPE[(size_t)row * 32 + k] = cosf(ang); ROPE[(size_t)row * 32 + 16 + k] = sinf(ang); }
}
typedef float f32x16 __attribute__((ext_vector_type(16)));
typedef short s16x4 __attribute__((ext_vector_type(4)));
typedef unsigned v2u __attribute__((ext_vector_type(2)));
__device__ __forceinline__ float bflo(unsigned u) { return __uint_as_float(u << 16); }
__device__ __forceinline__ float bfhi(unsigned u) { return __uint_as_float(u & 0xffff0000u); }
__device__ __forceinline__ void unpack8(const v4u r, float (&f)[8]) { f[0] = bflo(r.x); f[1] = bfhi(r.x); f[2] = bflo(r.y); f[3] = bfhi(r.y); f[4] = bflo(r.z); f[5] = bfhi(r.z); f[6] = bflo(r.w); f[7] = bfhi(r.w); }
__device__ __forceinline__ unsigned pkbf2(float lo, float hi) { typedef float f2 __attribute__((ext_vector_type(2))); typedef __bf16 b2 __attribute__((ext_vector_type(2))); f2 v = {lo, hi}; b2 b = __builtin_convertvector(v, b2); return __builtin_bit_cast(unsigned, b); }
template <int WIN> __device__ __forceinline__ void evenmix_pool(const bf16_t* zb  , int tta, LAS unsigned char* dst  , int RS) {
    v4u xr[WIN + 7];
#pragma unroll
    for (int i = 0; i < WIN + 7; ++i) { const int d = i - (WIN - 1); const bool ok = tta + d >= 0; xr[i] = *(const GAS v4u*)(zb + (ok ? (long)d * 2048 : 0)); if (!ok) xr[i] = (v4u){0u, 0u, 0u, 0u}; }
    float sm[8];
#pragma unroll
    for (int e = 0; e < 8; ++e) sm[e] = 0.f;
#pragma unroll
    for (int i = 0; i < WIN - 1; ++i) { float xv[8]; unpack8(xr[i], xv);
#pragma unroll
        for (int e = 0; e < 8; ++e) sm[e] += xv[e]; }
#pragma unroll
    for (int j = 0; j < 8; ++j) { float x0[8]; unpack8(xr[j + WIN - 1], x0);
        const int tt = tta + j; const int cnt = (tt + 1 < WIN) ? tt + 1 : WIN; const float ic = 1.f / (float)cnt;
#pragma unroll
        for (int e = 0; e < 8; ++e) sm[e] += x0[e];
        v4u dq; dq.x = pkbf2(sm[0] * ic - x0[0], sm[1] * ic - x0[1]); dq.y = pkbf2(sm[2] * ic - x0[2], sm[3] * ic - x0[3]); dq.z = pkbf2(sm[4] * ic - x0[4], sm[5] * ic - x0[5]); dq.w = pkbf2(sm[6] * ic - x0[6], sm[7] * ic - x0[7]);
        *(LAS v4u*)(dst + j * RS) = dq;
        float xo[8]; unpack8(xr[j], xo);
#pragma unroll
        for (int e = 0; e < 8; ++e) sm[e] -= xo[e]; }
}
__device__ __forceinline__ void evenmix_phase(Frame& F, const Args& args) {
    constexpr int RS = 1040;
    unsigned char* ws = args.ws; const bf16_t* Z = (const bf16_t*)(ws + WS_Z); bf16_t* YMIX = (bf16_t*)(ws + WS_YMIX);
    const bf16_t* WP = (const bf16_t*)(ws + WS_WB) + WB_POOL; const float* conv_w = args.in[13]; const float* pscale = args.in[15];
    int tid = threadIdx.x; asm volatile("" : "+v"(tid));
    const int lane = tid & 63, wave = __builtin_amdgcn_readfirstlane(tid >> 6), fr = lane & 15, fq = lane >> 4;
    const int gi = wave >> 1, nh = wave & 1;
    const int c0 = gi * 128 + 8 * (lane & 15);
    for (int tile = F.vcu; tile < MTOK / 64; tile += F.G) {
        const int row0 = tile * 64, rl0 = nh * 32 + 8 * (lane >> 4), rowa = row0 + rl0, tta = rowa & (SEQ - 1);
        const bf16_t* zb = Z + (size_t)rowa * 2048 + c0;
        { v4u gb[8], gc[10], xa[10]; float cw[3][8];
#pragma unroll
          for (int j = 0; j < 8; ++j) gb[j] = *(const GAS v4u*)(zb + (size_t)j * 2048);
#pragma unroll
          for (int j = 0; j < 10; ++j) { const bool ok = tta + j - 2 >= 0; const bf16_t* zp = zb + (ok ? ((long)j - 2) * 2048 : 0);
              gc[j] = *(const GAS v4u*)(zp + 512); xa[j] = *(const GAS v4u*)(zp + 1024); if (!ok) { gc[j] = (v4u){0u, 0u, 0u, 0u}; xa[j] = (v4u){0u, 0u, 0u, 0u}; } }
#pragma unroll
          for (int k = 0; k < 3; ++k)
#pragma unroll
              for (int e = 0; e < 8; ++e) cw[k][e] = conv_w[k * 512 + c0 + e];
#pragma unroll
          for (int j = 0; j < 8; ++j) { float acc[8], a_[8], b_[8];
#pragma unroll
              for (int e = 0; e < 8; ++e) acc[e] = 0.f;
#pragma unroll
              for (int k = 0; k < 3; ++k) { unpack8(gc[j + k], a_); unpack8(xa[j + k], b_);
#pragma unroll
                  for (int e = 0; e < 8; ++e) acc[e] += cw[k][e] * (a_[e] * b_[e]); }
              unpack8(gb[j], a_);
              v4u o; o.x = pkbf2(a_[0] * acc[0], a_[1] * acc[1]); o.y = pkbf2(a_[2] * acc[2], a_[3] * acc[3]); o.z = pkbf2(a_[4] * acc[4], a_[5] * acc[5]); o.w = pkbf2(a_[6] * acc[6], a_[7] * acc[7]);
              *(GAS v4u*)(YMIX + (size_t)(rowa + j) * 1024 + c0) = o; } }
        { LAS unsigned char* dst = F.lds + rl0 * RS + c0 * 2;
          if (gi == 0) evenmix_pool<2>(zb + 1536, tta, dst, RS); else if (gi == 1) evenmix_pool<4>(zb + 1536, tta, dst, RS); else if (gi == 2) evenmix_pool<8>(zb + 1536, tta, dst, RS); else evenmix_pool<16>(zb + 1536, tta, dst, RS); }
        pg8::bf16x8 Bf[4][4];
#pragma unroll
        for (int nt = 0; nt < 4; ++nt)
#pragma unroll
            for (int ks = 0; ks < 4; ++ks) Bf[nt][ks] = *(const pg8::bf16x8*)(WP + (size_t)gi * 128 * 128 + (size_t)(nh * 64 + nt * 16 + fr) * 128 + ks * 32 + 8 * fq);
        __syncthreads();
        pg8::f32x4 acc[4][4];
#pragma unroll
        for (int mt = 0; mt < 4; ++mt)
#pragma unroll
            for (int nt = 0; nt < 4; ++nt) acc[mt][nt] = (pg8::f32x4){0.f, 0.f, 0.f, 0.f};
#pragma unroll
        for (int ks = 0; ks < 4; ++ks) {
            pg8::bf16x8 Af[4];
#pragma unroll
            for (int mt = 0; mt < 4; ++mt) Af[mt] = *(const LAS pg8::bf16x8*)(F.lds + (mt * 16 + fr) * RS + (gi * 128 + ks * 32 + 8 * fq) * 2);
#pragma unroll
            for (int mt = 0; mt < 4; ++mt)
#pragma unroll
                for (int nt = 0; nt < 4; ++nt) acc[mt][nt] = __builtin_amdgcn_mfma_f32_16x16x32_bf16(Bf[nt][ks], Af[mt], acc[mt][nt], 0, 0, 0);
        }
#pragma unroll
        for (int nt = 0; nt < 4; ++nt) { const int col = gi * 128 + nh * 64 + nt * 16 + 4 * fq; const pg8::f32x4 sc = *(const pg8::f32x4*)(pscale + col);
#pragma unroll
            for (int mt = 0; mt < 4; ++mt) { const pg8::f32x4 v = acc[mt][nt] * sc; v2u w; w.x = pkbf2(v[0], v[1]); w.y = pkbf2(v[2], v[3]);
                *(GAS v2u*)(YMIX + (size_t)(row0 + mt * 16 + fr) * 1024 + 512 + col) = w; } }
        __syncthreads();
    }
}
typedef short v4i16_t __attribute__((ext_vector_type(4)));
__device__ __forceinline__ s16x4 vtr(const LAS unsigned char* p) { return __builtin_bit_cast(s16x4, __builtin_amdgcn_ds_read_tr16_b64_v4i16((LAS v4i16_t*)p)); }
__device__ __forceinline__ pg8::bf16x8 cat8(const s16x4 lo, const s16x4 hi) { return (pg8::bf16x8){lo[0], lo[1], lo[2], lo[3], hi[0], hi[1], hi[2], hi[3]}; }
__device__ __forceinline__ float xhalf_max(float m) { auto rr = __builtin_amdgcn_permlane32_swap(__float_as_uint(m), __float_as_uint(m), false, false); return fmaxf(__uint_as_float(rr[0]), __uint_as_float(rr[1])); }
__device__ __forceinline__ float xhalf_sum(float m) { auto rr = __builtin_amdgcn_permlane32_swap(__float_as_uint(m), __float_as_uint(m), false, false); return __uint_as_float(rr[0]) + __uint_as_float(rr[1]); }
__device__ __forceinline__ void xattn_phase(Frame& F, const Args& args, int l) {
    constexpr int RSK = 272, RSV = 320;
    unsigned char* ws = args.ws; const bf16_t* QX = (const bf16_t*)(ws + WS_Z); bf16_t* OX = (bf16_t*)(ws + WS_Z) + (size_t)MTOK * 512;
    const bf16_t* MKV = (const bf16_t*)(ws + WS_MEMKV) + (size_t)l * 1024 * 1024;
    int tid = threadIdx.x; asm volatile("" : "+v"(tid));
    const int lane = tid & 63, wave = __builtin_amdgcn_readfirstlane(tid >> 6), r32 = lane & 31, h5 = lane >> 5;
    const float C2 = 0.08838834764831845f * 1.4426950408889634f;
    for (int u = F.vcu; u < (MTOK / 256) * 4; u += F.G) {
        const int qt = u >> 2, h = u & 3, b = qt >> 4;
        const bf16_t* Kg = MKV + (size_t)(b * NMEM) * 1024 + h * 128; const bf16_t* Vg = Kg + 512;
        { v4u st[8];
#pragma unroll
          for (int i = 0; i < 8; ++i) { const int c = tid + 512 * i, key = c >> 4, ch = c & 15; st[i] = *(const GAS v4u*)(Kg + (size_t)key * 1024 + ch * 8); }
#pragma unroll
          for (int i = 0; i < 8; ++i) { const int c = tid + 512 * i, key = c >> 4, ch = c & 15; *(LAS v4u*)(F.lds + key * RSK + ch * 16) = st[i]; } }
        const int qrow = qt * 256 + wave * 32 + r32;
        pg8::bf16x8 qf[8];
#pragma unroll
        for (int kd = 0; kd < 8; ++kd) qf[kd] = *(const pg8::bf16x8*)(QX + (size_t)qrow * 512 + h * 128 + kd * 16 + 8 * h5);
        __syncthreads();
        f32x16 sa[8];
#pragma unroll
        for (int kb = 0; kb < 8; ++kb) { sa[kb] = (f32x16){};
#pragma unroll
            for (int kd = 0; kd < 8; ++kd) { const pg8::bf16x8 kf = *(const LAS pg8::bf16x8*)(F.lds + (kb * 32 + r32) * RSK + (kd * 16 + 8 * h5) * 2);
                sa[kb] = __builtin_amdgcn_mfma_f32_32x32x16_bf16(kf, qf[kd], sa[kb], 0, 0, 0); } }
        __syncthreads();
        { v4u st[8];
#pragma unroll
          for (int i = 0; i < 8; ++i) { const int c = tid + 512 * i, key = c >> 4, ch = c & 15; st[i] = *(const GAS v4u*)(Vg + (size_t)key * 1024 + ch * 8); }
#pragma unroll
          for (int i = 0; i < 8; ++i) { const int c = tid + 512 * i, key = c >> 4, ch = c & 15; *(LAS v4u*)(F.lds + key * RSV + ch * 16) = st[i]; } }
        float m = -INFINITY;
#pragma unroll
        for (int kb = 0; kb < 8; ++kb)
#pragma unroll
            for (int r = 0; r < 16; ++r) m = fmaxf(m, sa[kb][r]);
        m = xhalf_max(m);
        float lsum = 0.f; unsigned pk[8][8];
#pragma unroll
        for (int kb = 0; kb < 8; ++kb) {
#pragma unroll
            for (int r = 0; r < 16; ++r) { sa[kb][r] = __builtin_amdgcn_exp2f((sa[kb][r] - m) * C2); lsum += sa[kb][r]; }
#pragma unroll
            for (int r = 0; r < 8; ++r) pk[kb][r] = pkbf2(sa[kb][2 * r], sa[kb][2 * r + 1]); }
        lsum = xhalf_sum(lsum);
        const float inv = 1.f / lsum;
        __syncthreads();
        const int g = lane >> 4, i16 = lane & 15;
        const LAS unsigned char* vb = F.lds + (4 * (g >> 1) + (i16 >> 2)) * RSV + (16 * (g & 1) + 4 * (i16 & 3)) * 2;
        f32x16 o[4];
#pragma unroll
        for (int d = 0; d < 4; ++d) o[d] = (f32x16){};
#pragma unroll
        for (int kb = 0; kb < 8; ++kb)
#pragma unroll
            for (int s2 = 0; s2 < 2; ++s2) { const pg8::bf16x8 pb = __builtin_bit_cast(pg8::bf16x8, (v4u){pk[kb][4 * s2], pk[kb][4 * s2 + 1], pk[kb][4 * s2 + 2], pk[kb][4 * s2 + 3]});
#pragma unroll
                for (int d = 0; d < 4; ++d) { const LAS unsigned char* vp = vb + (kb * 32 + 16 * s2) * RSV + d * 64;
                    const pg8::bf16x8 vf = cat8(vtr(vp), vtr(vp + 8 * RSV));
                    o[d] = __builtin_amdgcn_mfma_f32_32x32x16_bf16(vf, pb, o[d], 0, 0, 0); } }
#pragma unroll
        for (int d = 0; d < 4; ++d)
#pragma unroll
            for (int gq = 0; gq < 4; ++gq) { v2u w; w.x = pkbf2(o[d][4 * gq] * inv, o[d][4 * gq + 1] * inv); w.y = pkbf2(o[d][4 * gq + 2] * inv, o[d][4 * gq + 3] * inv);
                *(GAS v2u*)(OX + (size_t)qrow * 512 + h * 128 + d * 32 + 8 * gq + 4 * h5) = w; }
        __syncthreads();
    }
}
constexpr size_t WS_MLGS = WS_FCUM;
constexpr size_t WS_MLBC = WS_FCUM + 256 * 1024;
constexpr size_t WS_MLN = WS_EXT;
constexpr size_t WS_MLG = WS_EXT + 1 * MiB;
constexpr size_t WS_MLC = WS_WB;
static_assert(WB_ODIN * 2 >= 16 * MiB, "C_loc overlays only layer-0 weights");
__device__ __forceinline__ float wave_incl_scan_add(float v, int lane) {
#pragma unroll
    for (int o = 1; o < 64; o <<= 1) { const float t = __shfl_up(v, o); if (lane >= o) v += t; }
    return v;
}
__device__ __forceinline__ float wave_incl_scan_max(float v, int lane) {
#pragma unroll
    for (int o = 1; o < 64; o <<= 1) { const float t = __shfl_up(v, o); if (lane >= o) v = fmaxf(v, t); }
    return v;
}
__device__ __forceinline__ float wave_max(float v) {
#pragma unroll
    for (int o = 1; o < 64; o <<= 1) v = fmaxf(v, __shfl_xor(v, o));
    return v;
}
template <int PASS> __device__ __forceinline__ void mlstm_phase(Frame& F, const Args& args, int u_first, int u_stride) {
    constexpr int RSV = 320, RSC = 272;
    constexpr float SCL = 0.08838834764831845f, L2E = 1.4426950408889634f;
    unsigned char* ws = args.ws; const bf16_t* Z1 = (const bf16_t*)(ws + WS_Z); const float* GATES = (const float*)(ws + WS_GATES);
    float* GS = (float*)(ws + WS_MLGS); float* BC = (float*)(ws + WS_MLBC); float* NL = (float*)(ws + WS_MLN); float* MG = (float*)(ws + WS_MLG); bf16_t* CL = (bf16_t*)(ws + WS_MLC);
    bf16_t* YM = (bf16_t*)(ws + WS_YMIX); const float* normg = args.in[19];
    int tid = threadIdx.x; asm volatile("" : "+v"(tid));
    const int lane = tid & 63, wave = __builtin_amdgcn_readfirstlane(tid >> 6), r32 = lane & 31, h5 = lane >> 5;
    const int g16 = lane >> 4, i16 = lane & 15;
    LAS unsigned char* const lds = F.lds;
    if constexpr (PASS == 0) {
        LAS float* warr = (LAS float*)(lds + 81920); LAS float* wtot = (LAS float*)(lds + 81920 + 1024); LAS float* npart = (LAS float*)(lds + 81920 + 2048);
        const int tro = (8 * (g16 >> 1) + (i16 >> 2)) * RSV + (16 * (g16 & 1) + 4 * (i16 & 3)) * 2;
        for (int u = u_first; u < 256; u += u_stride) {
            const int bh = u >> 4, c = u & 15, b = bh >> 2, h = bh & 3; const size_t row0 = (size_t)b * SEQ + c * 256;
            float lf = 0.f, ig = 0.f, sc = 0.f;
            if (tid < 256) { const float f = GATES[(row0 + tid) * 8 + 4 + h]; ig = GATES[(row0 + tid) * 8 + h]; lf = fminf(f, 0.f) - log1pf(__expf(-fabsf(f))); sc = wave_incl_scan_add(lf, lane); if (lane == 63) wtot[wave] = sc; }
            __syncthreads();
            const float t0 = wtot[0], t1 = wtot[1], t2 = wtot[2], t3 = wtot[3], gtot = (t0 + t1) + (t2 + t3);
            float a = -INFINITY, bcum = 0.f;
            if (tid < 256) { bcum = sc + (wave > 0 ? t0 : 0.f) + (wave > 1 ? t1 : 0.f) + (wave > 2 ? t2 : 0.f); a = gtot - bcum + ig; const float wm = wave_max(a); if (lane == 0) wtot[4 + wave] = wm;
                GS[(size_t)h * MTOK + row0 + tid] = ig - bcum; BC[(size_t)h * MTOK + row0 + tid] = bcum; }
            __syncthreads();
            const float mloc = fmaxf(fmaxf(wtot[4], wtot[5]), fmaxf(wtot[6], wtot[7]));
            if (tid < 256) warr[tid] = __expf(a - mloc);
            if (tid == 0) { MG[u * 2] = mloc; MG[u * 2 + 1] = gtot; }
            f32x16 acc[2]; acc[0] = (f32x16){}; acc[1] = (f32x16){};
            float np = 0.f;
            const int vb = wave >> 1, kb0 = (wave & 1) * 2;
#pragma unroll 1
            for (int half = 0; half < 2; ++half) {
                __syncthreads();
                { v4u kst[4], vst[4];
#pragma unroll
                  for (int i = 0; i < 4; ++i) { const int cc = tid + 512 * i, rr = cc >> 4, ch = cc & 15; const size_t grow = row0 + half * 128 + rr;
                      kst[i] = *(const GAS v4u*)(Z1 + grow * 2816 + 512 + h * 128 + ch * 8); vst[i] = *(const GAS v4u*)(Z1 + grow * 2816 + 1024 + h * 128 + ch * 8); }
#pragma unroll
                  for (int i = 0; i < 4; ++i) { const int cc = tid + 512 * i, rr = cc >> 4, ch = cc & 15;
                      *(LAS v4u*)(lds + rr * RSV + ch * 16) = kst[i];
                      float vv[8]; unpack8(vst[i], vv); const float w = warr[half * 128 + rr];
                      v4u o; o.x = pkbf2(vv[0] * w, vv[1] * w); o.y = pkbf2(vv[2] * w, vv[3] * w); o.z = pkbf2(vv[4] * w, vv[5] * w); o.w = pkbf2(vv[6] * w, vv[7] * w);
                      *(LAS v4u*)(lds + 40960 + rr * RSV + ch * 16) = o; } }
                __syncthreads();
#pragma unroll
                for (int ks = 0; ks < 8; ++ks) { const LAS unsigned char* vp = lds + 40960 + tro + 16 * ks * RSV + vb * 64;
                    const pg8::bf16x8 af = cat8(vtr(vp), vtr(vp + 4 * RSV));
#pragma unroll
                    for (int j = 0; j < 2; ++j) { const LAS unsigned char* kp = lds + tro + 16 * ks * RSV + (kb0 + j) * 64;
                        const pg8::bf16x8 bf = cat8(vtr(kp), vtr(kp + 4 * RSV));
                        acc[j] = __builtin_amdgcn_mfma_f32_32x32x16_bf16(af, bf, acc[j], 0, 0, 0); } }
                { const int k = tid & 127, sq = tid >> 7;
#pragma unroll 8
                  for (int rr = 0; rr < 32; ++rr) { const int s_ = sq * 32 + rr; const unsigned short kv = *(const LAS unsigned short*)(lds + s_ * RSV + k * 2); np += warr[half * 128 + s_] * __uint_as_float(((unsigned)kv) << 16); } }
            }
            npart[tid] = np;
            bf16_t* cl = CL + (size_t)u * 16384;
#pragma unroll
            for (int j = 0; j < 2; ++j)
#pragma unroll
                for (int r = 0; r < 16; ++r) cl[(size_t)(vb * 32 + (r & 3) + 8 * (r >> 2) + 4 * h5) * 128 + (kb0 + j) * 32 + r32] = (bf16_t)(pkbf2(acc[j][r] * SCL, 0.f) & 0xffffu);
            __syncthreads();
            if (tid < 128) NL[(size_t)u * 128 + tid] = ((npart[tid] + npart[128 + tid]) + (npart[256 + tid] + npart[384 + tid])) * SCL;
            __syncthreads();
        }
    }
    if constexpr (PASS == 1) {
        LAS unsigned char* const Cl = lds + 81920;
        LAS float* gsl = (LAS float*)(lds + 125440); LAS float* Mtl = (LAS float*)(lds + 126464); LAS float* bcl = (LAS float*)(lds + 127488); LAS float* wtot = (LAS float*)(lds + 128512);
        const int vbo = (4 * (g16 >> 1) + (i16 >> 2)) * RSV + (16 * (g16 & 1) + 4 * (i16 & 3)) * 2;
        for (int u = u_first; u < 256; u += u_stride) {
            const int bh = u >> 4, c = u & 15, b = bh >> 2, h = bh & 3; const size_t row0 = (size_t)b * SEQ + c * 256;
            float mprev = -INFINITY;
            { float ml[16], gt[16];
#pragma unroll
              for (int cp = 0; cp < 16; ++cp) { const v2u mg = *(const GAS v2u*)(MG + (bh * 16 + cp) * 2); ml[cp] = __uint_as_float(mg.x); gt[cp] = __uint_as_float(mg.y); }
              float G = 0.f;
#pragma unroll
              for (int cp = 15; cp >= 0; --cp) if (cp < c) { mprev = fmaxf(mprev, G + ml[cp]); G += gt[cp]; }
              G = 0.f; float mine = 0.f;
#pragma unroll
              for (int cp = 15; cp >= 0; --cp) if (cp < c) { const float e = __expf(G + ml[cp] - mprev); G += gt[cp]; if (tid == cp) mine = e; }
              if (tid < 16) wtot[16 + tid] = mine; }
            __syncthreads();
            { f32x4 a4[8];
#pragma unroll
              for (int i = 0; i < 8; ++i) a4[i] = (f32x4){0.f, 0.f, 0.f, 0.f};
              f32x4 n4 = (f32x4){0.f, 0.f, 0.f, 0.f};
              v4u cA[4], cB[4]; f32x4 nA, nB;
#define MLC_LOAD(S, NV, cp_) do { const int cq_ = (cp_) > 0 ? (cp_) : 0; const bf16_t* cl_ = CL + (size_t)(bh * 16 + cq_) * 16384; \
                  _Pragma("unroll") for (int i = 0; i < 4; ++i) S[i] = *(const GAS v4u*)(cl_ + tid * 8 + 4096 * i); \
                  NV = *(const GAS f32x4*)(NL + (size_t)(bh * 16 + cq_) * 128 + (tid & 31) * 4); } while (0)
#define MLC_ACC(S, NV, e_) do { _Pragma("unroll") for (int i = 0; i < 4; ++i) { float f8[8]; unpack8(S[i], f8); \
                      a4[2 * i] += (f32x4){f8[0], f8[1], f8[2], f8[3]} * (e_); a4[2 * i + 1] += (f32x4){f8[4], f8[5], f8[6], f8[7]} * (e_); } \
                  n4 += NV * (e_); } while (0)
              MLC_LOAD(cA, nA, c - 1); MLC_LOAD(cB, nB, c - 2);
              for (int cp = c - 1; cp >= 0; cp -= 2) {
                  const float eA = wtot[16 + cp], eB = (cp >= 1) ? wtot[16 + (cp >= 1 ? cp - 1 : 0)] : 0.f;
                  MLC_ACC(cA, nA, eA); MLC_LOAD(cA, nA, cp - 2);
                  MLC_ACC(cB, nB, eB); MLC_LOAD(cB, nB, cp - 3); }
#undef MLC_LOAD
#undef MLC_ACC
#pragma unroll
              for (int i = 0; i < 4; ++i) { const int e0 = tid * 8 + 4096 * i, v = e0 >> 7, k = e0 & 127; v4u w; w.x = pkbf2(a4[2 * i][0], a4[2 * i][1]); w.y = pkbf2(a4[2 * i][2], a4[2 * i][3]); w.z = pkbf2(a4[2 * i + 1][0], a4[2 * i + 1][1]); w.w = pkbf2(a4[2 * i + 1][2], a4[2 * i + 1][3]);
                  *(LAS v4u*)(Cl + v * RSC + k * 2) = w; }
              if (tid < 32) { v2u w; w.x = pkbf2(n4[0], n4[1]); w.y = pkbf2(n4[2], n4[3]); *(LAS v2u*)(Cl + 128 * RSC + tid * 8) = w; }
              for (int e0 = tid; e0 < 31 * 32; e0 += 512) { const int v = 129 + e0 / 32, k4 = e0 % 32; *(LAS v2u*)(Cl + v * RSC + k4 * 8) = (v2u){0u, 0u}; } }
            { v4u st[8];
#pragma unroll
              for (int i = 0; i < 8; ++i) { const int cc = tid + 512 * i, rr = cc >> 4, ch = cc & 15; st[i] = *(const GAS v4u*)(Z1 + (row0 + rr) * 2816 + 1024 + h * 128 + ch * 8); }
#pragma unroll
              for (int i = 0; i < 8; ++i) { const int cc = tid + 512 * i, rr = cc >> 4, ch = cc & 15; *(LAS v4u*)(lds + rr * RSV + ch * 16) = st[i]; } }
            const int tl = wave * 32 + r32; const size_t row = row0 + tl;
            pg8::bf16x8 qf[8];
#pragma unroll
            for (int kd = 0; kd < 8; ++kd) qf[kd] = *(const pg8::bf16x8*)(Z1 + row * 2816 + h * 128 + kd * 16 + 8 * h5);
            float pm = -INFINITY;
            if (tid < 256) { const float gsv = GS[(size_t)h * MTOK + row0 + tid]; gsl[tid] = gsv; bcl[tid] = BC[(size_t)h * MTOK + row0 + tid]; pm = wave_incl_scan_max(gsv, lane); if (lane == 63) wtot[wave] = pm; }
            __syncthreads();
            if (tid < 256) { float off = mprev; if (wave > 0) off = fmaxf(off, wtot[0]); if (wave > 1) off = fmaxf(off, wtot[1]); if (wave > 2) off = fmaxf(off, wtot[2]); Mtl[tid] = fmaxf(pm, off); }
            __syncthreads();
            const float Mt = Mtl[tl]; const float winter = __builtin_amdgcn_exp2f((mprev - Mt) * L2E);
            f32x16 o[4]; float dinter;
            { f32x16 o4 = (f32x16){};
#pragma unroll
              for (int d = 0; d < 4; ++d) o[d] = (f32x16){};
#pragma unroll
              for (int kd = 0; kd < 8; ++kd) {
#pragma unroll
                  for (int d = 0; d < 4; ++d) { const pg8::bf16x8 cf = *(const LAS pg8::bf16x8*)(Cl + (d * 32 + r32) * RSC + (kd * 16 + 8 * h5) * 2); o[d] = __builtin_amdgcn_mfma_f32_32x32x16_bf16(cf, qf[kd], o[d], 0, 0, 0); }
                  const pg8::bf16x8 cf = *(const LAS pg8::bf16x8*)(Cl + (128 + r32) * RSC + (kd * 16 + 8 * h5) * 2); o4 = __builtin_amdgcn_mfma_f32_32x32x16_bf16(cf, qf[kd], o4, 0, 0, 0); }
#pragma unroll
              for (int d = 0; d < 4; ++d)
#pragma unroll
                  for (int r = 0; r < 16; ++r) o[d][r] *= winter;
              dinter = xhalf_sum(o4[0]) * winter; }
            float dintra = 0.f;
            pg8::bf16x8 kfa[8], kfb[8];
            { const bf16_t* kg = Z1 + (row0 + r32) * 2816 + 512 + h * 128 + 8 * h5;
#pragma unroll
              for (int kd = 0; kd < 8; ++kd) kfa[kd] = *(const pg8::bf16x8*)(kg + kd * 16); }
#pragma unroll 1
            for (int sb = 0; sb <= wave; ++sb) {
                f32x16 sa = (f32x16){};
                { const int sn = (sb + 1 <= wave) ? sb + 1 : sb; const bf16_t* kg = Z1 + (row0 + sn * 32 + r32) * 2816 + 512 + h * 128 + 8 * h5;
#pragma unroll
                  for (int kd = 0; kd < 8; ++kd) kfb[kd] = *(const pg8::bf16x8*)(kg + kd * 16); }
#pragma unroll
                for (int kd = 0; kd < 8; ++kd) sa = __builtin_amdgcn_mfma_f32_32x32x16_bf16(kfa[kd], qf[kd], sa, 0, 0, 0);
#pragma unroll
                for (int gq = 0; gq < 4; ++gq) { const int sbase = sb * 32 + 8 * gq + 4 * h5; const f32x4 g4 = *(const LAS f32x4*)(gsl + sbase);
#pragma unroll
                    for (int e = 0; e < 4; ++e) { const int r = 4 * gq + e; float wgt = __builtin_amdgcn_exp2f((g4[e] - Mt) * L2E) * SCL; if (sbase + e > tl) wgt = 0.f; sa[r] *= wgt; dintra += sa[r]; } }
#pragma unroll
                for (int s2 = 0; s2 < 2; ++s2) { const pg8::bf16x8 pb = __builtin_bit_cast(pg8::bf16x8, (v4u){pkbf2(sa[8 * s2], sa[8 * s2 + 1]), pkbf2(sa[8 * s2 + 2], sa[8 * s2 + 3]), pkbf2(sa[8 * s2 + 4], sa[8 * s2 + 5]), pkbf2(sa[8 * s2 + 6], sa[8 * s2 + 7])});
#pragma unroll
                    for (int d = 0; d < 4; ++d) { const LAS unsigned char* vp = lds + vbo + (sb * 32 + 16 * s2) * RSV + d * 64; const pg8::bf16x8 vf = cat8(vtr(vp), vtr(vp + 8 * RSV));
                        o[d] = __builtin_amdgcn_mfma_f32_32x32x16_bf16(vf, pb, o[d], 0, 0, 0); } }
#pragma unroll
                for (int kd = 0; kd < 8; ++kd) kfa[kd] = kfb[kd];
            }
            const float denr = dinter + xhalf_sum(dintra); const float mt = bcl[tl] + Mt; const float inv = 1.f / fmaxf(fabsf(denr), __expf(-mt));
            float ss = 0.f;
            { v2u og[4][4];
#pragma unroll
              for (int d = 0; d < 4; ++d)
#pragma unroll
                  for (int gq = 0; gq < 4; ++gq) og[d][gq] = *(const GAS v2u*)(Z1 + row * 2816 + 1536 + h * 128 + d * 32 + 8 * gq + 4 * h5);
#pragma unroll
              for (int d = 0; d < 4; ++d)
#pragma unroll
                  for (int gq = 0; gq < 4; ++gq) { const float g0 = bflo(og[d][gq].x), g1 = bfhi(og[d][gq].x), g2 = bflo(og[d][gq].y), g3 = bfhi(og[d][gq].y);
                      o[d][4 * gq] = o[d][4 * gq] * inv / (1.f + __expf(-g0)); o[d][4 * gq + 1] = o[d][4 * gq + 1] * inv / (1.f + __expf(-g1));
                      o[d][4 * gq + 2] = o[d][4 * gq + 2] * inv / (1.f + __expf(-g2)); o[d][4 * gq + 3] = o[d][4 * gq + 3] * inv / (1.f + __expf(-g3));
                      ss += (o[d][4 * gq] * o[d][4 * gq] + o[d][4 * gq + 1] * o[d][4 * gq + 1]) + (o[d][4 * gq + 2] * o[d][4 * gq + 2] + o[d][4 * gq + 3] * o[d][4 * gq + 3]); } }
            const float rstd = rsqrtf(xhalf_sum(ss) * (1.f / 128.f) + 1e-6f);
#pragma unroll
            for (int d = 0; d < 4; ++d) { f32x4 gn[4];
#pragma unroll
                for (int gq = 0; gq < 4; ++gq) gn[gq] = *(const GAS f32x4*)(normg + h * 128 + d * 32 + 8 * gq + 4 * h5);
#pragma unroll
                for (int gq = 0; gq < 4; ++gq) { const int v0 = h * 128 + d * 32 + 8 * gq + 4 * h5;
                    v2u w; w.x = pkbf2(o[d][4 * gq] * rstd * gn[gq][0], o[d][4 * gq + 1] * rstd * gn[gq][1]); w.y = pkbf2(o[d][4 * gq + 2] * rstd * gn[gq][2], o[d][4 * gq + 3] * rstd * gn[gq][3]);
                    *(GAS v2u*)(YM + row * 1024 + v0) = w; } }
            __syncthreads();
        }
    }
}
__device__ __forceinline__ float max3f_(float a, float b, float c) { float r; asm("v_max3_f32 %0, %1, %2, %3" : "=v"(r) : "v"(a), "v"(b), "v"(c)); return r; }
__device__ __forceinline__ float max2f_(float a, float b) { float r; asm("v_max_f32_e32 %0, %1, %2" : "=v"(r) : "v"(a), "v"(b)); return r; }
__device__ __forceinline__ float fadd_(float a, float b) { float r; asm("v_add_f32_e32 %0, %1, %2" : "=v"(r) : "v"(a), "v"(b)); return r; }
template <int ABL> __device__ __forceinline__ void mla_attn_phase(Frame& F, const Args& args, bf16_t* YM, int ldy) {
    constexpr int RSK = 208, RSV = 192, KB = 128 * RSK, VB = 128 * RSV, SLOT = KB + VB;
    unsigned char* ws = args.ws; const bf16_t* QM = (const bf16_t*)args.out  ; const bf16_t* KM = QM + (size_t)MTOK * 768; const bf16_t* VM = KM + (size_t)MTOK * 768;
    int tid = threadIdx.x; asm volatile("" : "+v"(tid));
    const int lane = tid & 63, wave = __builtin_amdgcn_readfirstlane(tid >> 6), r32 = lane & 31, h5 = lane >> 5;
    const float C2 = 0.10206207261596575f * 1.4426950408889634f;
    const int g = lane >> 4, i16 = lane & 15;
    const int vboff = (4 * (g >> 1) + (i16 >> 2)) * RSV + (16 * (g & 1) + 4 * (i16 & 3)) * 2;
    int kgo[3], klo[3];
#pragma unroll
    for (int i = 0; i < 3; ++i) { const int id = tid + 512 * i, key = id / 12, ch = id % 12; kgo[i] = key * 768 + ch * 8; klo[i] = key * RSK + ch * 16; }
#define VGO(i) (((tid + 512 * (i)) >> 3) * 512 + ((tid + 512 * (i)) & 7) * 8)
#define VLO(i) (KB + ((tid + 512 * (i)) >> 3) * RSV + ((tid + 512 * (i)) & 7) * 16)
    if (wave < 4) __builtin_amdgcn_s_setprio(2);
    for (int pid = F.vcu; pid < 256; pid += F.G) {
        const int bh = pid >> 3, b = bh >> 3, h = bh & 7;
#pragma unroll 1
        for (int half = 0; half < 2; ++half) {
            const int qb = half ? 15 - (pid & 7) : (pid & 7);
            const int q0w = qb * 256 + wave * 32, NT = 2 * qb + 2;
            const size_t rowb = (size_t)b * SEQ;
            const bf16_t* Kg = KM + rowb * 768 + h * 96; const bf16_t* Vg = VM + rowb * 512 + h * 64;
            pg8::bf16x8 qf[6];
#pragma unroll
            for (int kd = 0; kd < 6; ++kd) { const v4u raw = *(const GAS v4u*)(QM + (rowb + q0w + r32) * 768 + h * 96 + kd * 16 + 8 * h5); float f8[8]; unpack8(raw, f8);
                v4u w; w.x = pkbf2(f8[0] * C2, f8[1] * C2); w.y = pkbf2(f8[2] * C2, f8[3] * C2); w.z = pkbf2(f8[4] * C2, f8[5] * C2); w.w = pkbf2(f8[6] * C2, f8[7] * C2); qf[kd] = __builtin_bit_cast(pg8::bf16x8, w); }
            v4u sA[5];
#define MLA_LOAD(S, t) do { const bf16_t* kt = Kg + (size_t)(t) * 128 * 768; const bf16_t* vt = Vg + (size_t)(t) * 128 * 512; \
            S[0] = *(const GAS v4u*)(kt + kgo[0]); S[1] = *(const GAS v4u*)(kt + kgo[1]); S[2] = *(const GAS v4u*)(kt + kgo[2]); S[3] = *(const GAS v4u*)(vt + VGO(0)); S[4] = *(const GAS v4u*)(vt + VGO(1)); } while (0)
#define MLA_STORE(S, buf) do { LAS unsigned char* b_ = F.lds + (buf) * SLOT; \
            *(LAS v4u*)(b_ + klo[0]) = S[0]; *(LAS v4u*)(b_ + klo[1]) = S[1]; *(LAS v4u*)(b_ + klo[2]) = S[2]; *(LAS v4u*)(b_ + VLO(0)) = S[3]; *(LAS v4u*)(b_ + VLO(1)) = S[4]; } while (0)
            float mref = 0.f, lsum = 0.f; f32x16 o[2]; o[0] = (f32x16){}; o[1] = (f32x16){}; f32x16 negm = (f32x16){}; bool first = true;
#define MLA_SUB(kbp, vbp, kbase) do { if ((kbase) <= q0w + 31) { \
                f32x16 s0 = negm, s1 = negm; \
                pg8::bf16x8 kf[12]; \
                if (!(ABL & 4)) { \
                _Pragma("unroll") for (int kd = 0; kd < 6; ++kd) { kf[2 * kd] = *(const LAS pg8::bf16x8*)((kbp) + r32 * RSK + (kd * 16 + 8 * h5) * 2); kf[2 * kd + 1] = *(const LAS pg8::bf16x8*)((kbp) + (32 + r32) * RSK + (kd * 16 + 8 * h5) * 2); } \
                __builtin_amdgcn_sched_barrier(0); \
                _Pragma("unroll") for (int kd = 0; kd < 6; ++kd) { s0 = __builtin_amdgcn_mfma_f32_32x32x16_bf16(kf[2 * kd], qf[kd], s0, 0, 0, 0); s1 = __builtin_amdgcn_mfma_f32_32x32x16_bf16(kf[2 * kd + 1], qf[kd], s1, 0, 0, 0); } } \
                s16x4 vl[8], vh[8]; \
                if (!(ABL & 2)) _Pragma("unroll") for (int ks = 0; ks < 4; ++ks) _Pragma("unroll") for (int d = 0; d < 2; ++d) { const LAS unsigned char* vp = (vbp) + vboff + (16 * ks) * RSV + d * 64; vl[2 * ks + d] = vtr(vp); vh[2 * ks + d] = vtr(vp + 8 * RSV); } \
                __builtin_amdgcn_sched_barrier(0); \
                if ((kbase) + 63 > q0w) { const int q = q0w + r32, k0i = (kbase) + 4 * h5; \
                    _Pragma("unroll") for (int r = 0; r < 16; ++r) { const int kv = k0i + (r & 3) + 8 * (r >> 2); if (kv > q) s0[r] = -INFINITY; if (kv + 32 > q) s1[r] = -INFINITY; } } \
                if (!(ABL & 1)) { \
                asm volatile("s_nop 15\n\ts_nop 7" : "+v"(s0), "+v"(s1));     \
                float mxa = max3f_(s0[0], s0[1], s1[0]), mxb = max3f_(s0[2], s0[3], s1[1]); mxa = max3f_(mxa, s1[2], s1[3]); \
                _Pragma("unroll") for (int r = 4; r < 16; r += 4) { mxa = max3f_(mxa, s0[r], s0[r + 1]); mxb = max3f_(mxb, s0[r + 2], s0[r + 3]); mxa = max3f_(mxa, s1[r], s1[r + 1]); mxb = max3f_(mxb, s1[r + 2], s1[r + 3]); } \
                float mx = xhalf_max(fmaxf(mxa, mxb));     \
                if (first || __any(mx > 8.0f)) { const float dl = first ? mx : fmaxf(mx, 0.f); first = false; mref += dl; const float alpha = __builtin_amdgcn_exp2f(-dl); lsum *= alpha; \
                    _Pragma("unroll") for (int r = 0; r < 16; ++r) { s0[r] -= dl; s1[r] -= dl; o[0][r] *= alpha; o[1][r] *= alpha; negm[r] = -mref; } } \
                float pa_ = 0.f, pb_ = 0.f, pc_ = 0.f, pd_ = 0.f; \
                _Pragma("unroll") for (int r = 0; r < 16; ++r) { s0[r] = __builtin_amdgcn_exp2f(s0[r]); s1[r] = __builtin_amdgcn_exp2f(s1[r]); } \
                _Pragma("unroll") for (int r = 0; r < 16; r += 2) { pa_ += s0[r]; pb_ += s0[r + 1]; pc_ += s1[r]; pd_ += s1[r + 1]; asm volatile("" : "+v"(pa_), "+v"(pb_), "+v"(pc_), "+v"(pd_)); }     \
                lsum += (pa_ + pb_) + (pc_ + pd_); } else { lsum += s0[0] + s1[5]; } \
                pg8::bf16x8 pb[4]; \
                _Pragma("unroll") for (int s2 = 0; s2 < 2; ++s2) { \
                    pb[s2] = __builtin_bit_cast(pg8::bf16x8, (v4u){pkbf2(s0[8 * s2], s0[8 * s2 + 1]), pkbf2(s0[8 * s2 + 2], s0[8 * s2 + 3]), pkbf2(s0[8 * s2 + 4], s0[8 * s2 + 5]), pkbf2(s0[8 * s2 + 6], s0[8 * s2 + 7])}); \
                    pb[2 + s2] = __builtin_bit_cast(pg8::bf16x8, (v4u){pkbf2(s1[8 * s2], s1[8 * s2 + 1]), pkbf2(s1[8 * s2 + 2], s1[8 * s2 + 3]), pkbf2(s1[8 * s2 + 4], s1[8 * s2 + 5]), pkbf2(s1[8 * s2 + 6], s1[8 * s2 + 7])}); } \
                if (!(ABL & 2)) { _Pragma("unroll") for (int ks = 0; ks < 4; ++ks) \
                    _Pragma("unroll") for (int d = 0; d < 2; ++d) o[d] = __builtin_amdgcn_mfma_f32_32x32x16_bf16(cat8(vl[2 * ks + d], vh[2 * ks + d]), pb[ks], o[d], 0, 0, 0); } \
                else { asm volatile("" :: "v"(pb[0]), "v"(pb[1]), "v"(pb[2]), "v"(pb[3])); } } } while (0)
#define MLA_TILE(t, buf) do { const LAS unsigned char* kb_ = F.lds + (buf) * SLOT; const LAS unsigned char* vb_ = kb_ + KB; \
                MLA_SUB(kb_, vb_, 128 * (t)); MLA_SUB(kb_ + 64 * RSK, vb_ + 64 * RSV, 128 * (t) + 64); } while (0)
#define MLA_QK(S0, S1, kbp) do { pg8::bf16x8 kf[12]; \
                _Pragma("unroll") for (int kd = 0; kd < 6; ++kd) { kf[2 * kd] = *(const LAS pg8::bf16x8*)((kbp) + r32 * RSK + (kd * 16 + 8 * h5) * 2); kf[2 * kd + 1] = *(const LAS pg8::bf16x8*)((kbp) + (32 + r32) * RSK + (kd * 16 + 8 * h5) * 2); } \
                _Pragma("unroll") for (int kd = 0; kd < 6; ++kd) { S0 = __builtin_amdgcn_mfma_f32_32x32x16_bf16(kf[2 * kd], qf[kd], S0, 0, 0, 0); S1 = __builtin_amdgcn_mfma_f32_32x32x16_bf16(kf[2 * kd + 1], qf[kd], S1, 0, 0, 0); } } while (0)
#define MLA_SM(S0, S1, PB) do { float mx = fmaxf(S0[0], S1[0]); \
                _Pragma("unroll") for (int r = 1; r < 16; ++r) mx = fmaxf(mx, fmaxf(S0[r], S1[r])); \
                mx = xhalf_max(mx) * C2; \
                const float mn = fmaxf(m, mx), alpha = __builtin_amdgcn_exp2f(m - mn); m = mn; \
                _Pragma("unroll") for (int r = 0; r < 16; ++r) { o[0][r] *= alpha; o[1][r] *= alpha; } \
                float ps = 0.f; \
                _Pragma("unroll") for (int r = 0; r < 16; ++r) { S0[r] = __builtin_amdgcn_exp2f(fmaf(S0[r], C2, -mn)); S1[r] = __builtin_amdgcn_exp2f(fmaf(S1[r], C2, -mn)); ps += S0[r] + S1[r]; } \
                lsum = lsum * alpha + ps; \
                _Pragma("unroll") for (int s2 = 0; s2 < 2; ++s2) { \
                    PB[s2] = __builtin_bit_cast(pg8::bf16x8, (v4u){pkbf2(S0[8 * s2], S0[8 * s2 + 1]), pkbf2(S0[8 * s2 + 2], S0[8 * s2 + 3]), pkbf2(S0[8 * s2 + 4], S0[8 * s2 + 5]), pkbf2(S0[8 * s2 + 6], S0[8 * s2 + 7])}); \
                    PB[2 + s2] = __builtin_bit_cast(pg8::bf16x8, (v4u){pkbf2(S1[8 * s2], S1[8 * s2 + 1]), pkbf2(S1[8 * s2 + 2], S1[8 * s2 + 3]), pkbf2(S1[8 * s2 + 4], S1[8 * s2 + 5]), pkbf2(S1[8 * s2 + 6], S1[8 * s2 + 7])}); } } while (0)
#define MLA_PV(PB, vbp) do { _Pragma("unroll") for (int ks = 0; ks < 4; ++ks) _Pragma("unroll") for (int d = 0; d < 2; ++d) { const LAS unsigned char* vp = (vbp) + vboff + (16 * ks) * RSV + d * 64; \
                o[d] = __builtin_amdgcn_mfma_f32_32x32x16_bf16(cat8(vtr(vp), vtr(vp + 8 * RSV)), PB[ks], o[d], 0, 0, 0); } } while (0)
#define MLA_FULL(buf) do { const LAS unsigned char* kb_ = F.lds + (buf) * SLOT; const LAS unsigned char* vb_ = kb_ + KB; \
                f32x16 a0 = (f32x16){}, a1 = (f32x16){}, b0 = (f32x16){}, b1 = (f32x16){}; pg8::bf16x8 pa[4], pbb[4]; \
                MLA_QK(a0, a1, kb_); \
                __builtin_amdgcn_sched_barrier(0); \
                MLA_QK(b0, b1, kb_ + 64 * RSK); MLA_SM(a0, a1, pa); \
                _Pragma("unroll") for (int i_ = 0; i_ < 12; ++i_) { __builtin_amdgcn_sched_group_barrier(0x100, 1, 0); __builtin_amdgcn_sched_group_barrier(0x8, 1, 0); __builtin_amdgcn_sched_group_barrier(0x2, 14, 0); } \
                __builtin_amdgcn_sched_barrier(0); \
                MLA_PV(pa, vb_); MLA_SM(b0, b1, pbb); \
                _Pragma("unroll") for (int i_ = 0; i_ < 8; ++i_) { __builtin_amdgcn_sched_group_barrier(0x100, 2, 1); __builtin_amdgcn_sched_group_barrier(0x8, 1, 1); __builtin_amdgcn_sched_group_barrier(0x2, 22, 1); } \
                __builtin_amdgcn_sched_barrier(0); \
                MLA_PV(pbb, vb_ + 64 * RSV); \
                __builtin_amdgcn_sched_barrier(0); } while (0)
            MLA_LOAD(sA, 0);
#pragma unroll
            for (int kd = 0; kd < 6; ++kd) asm volatile("" : "+v"(qf[kd]));
            MLA_STORE(sA, 0);
            __syncthreads();
            const int NFULL = 2 * qb;
#pragma unroll 1
            for (int t = 0; t < NT; ++t) {
                const int buf = t & 1;
                MLA_LOAD(sA, (t + 1 < NT ? t + 1 : NT - 1));
                MLA_TILE(t, buf); (void)NFULL;
                if (t + 1 < NT) MLA_STORE(sA, buf ^ 1);
                __syncthreads();
            }
            const float inv = 1.f / xhalf_sum(lsum);
#pragma unroll
            for (int d = 0; d < 2; ++d)
#pragma unroll
                for (int gq = 0; gq < 4; ++gq) { v2u w; w.x = pkbf2(o[d][4 * gq] * inv, o[d][4 * gq + 1] * inv); w.y = pkbf2(o[d][4 * gq + 2] * inv, o[d][4 * gq + 3] * inv);
                    *(GAS v2u*)(YM + (rowb + q0w + r32) * ldy + h * 64 + d * 32 + 8 * gq + 4 * h5) = w; }
#undef MLA_LOAD
#undef MLA_STORE
#undef MLA_SUB
#undef MLA_TILE
#undef MLA_QK
#undef MLA_SM
#undef MLA_PV
#undef MLA_FULL
#undef VGO
#undef VLO
        }
    }
    __builtin_amdgcn_s_setprio(0);
}
__device__ __forceinline__ void final_norm_phase(Frame& F, const Args& args, float tscale, float tadd) {
    int tid = threadIdx.x; asm volatile("" : "+v"(tid)); const int lane = tid & 63, wv = __builtin_amdgcn_readfirstlane(tid >> 6);
    const int gw = F.vcu * NWAVES + wv, NGW = F.G * NWAVES; const float* g = args.in[25]; float* X = args.out; const bf16_t* XB = (const bf16_t*)(args.ws + WS_XB);
    f32x4 gv[4];
#pragma unroll
    for (int j = 0; j < 4; ++j) gv[j] = ((const GAS f32x4*)g)[2 * lane + 128 * (j >> 1) + (j & 1)];
    for (int m = gw; m < MTOK; m += NGW) {
        const v4u r0 = *(const GAS v4u*)(XB + (size_t)m * DM + 8 * lane), r1 = *(const GAS v4u*)(XB + (size_t)m * DM + 512 + 8 * lane);
        float a[8], b[8]; unpack8(r0, a); unpack8(r1, b); float s = 0.f;
#pragma unroll
        for (int e = 0; e < 8; ++e) s += a[e] * a[e] + b[e] * b[e];
        const float rs = rsqrtf(wave_sum(s) * (1.f / 1024.f) + 1e-6f) * tscale;
        GAS f32x4* xr = (GAS f32x4*)(X + (size_t)m * DM);
        f32x4 o0 = (f32x4){a[0], a[1], a[2], a[3]} * rs * gv[0], o1 = (f32x4){a[4], a[5], a[6], a[7]} * rs * gv[1], o2 = (f32x4){b[0], b[1], b[2], b[3]} * rs * gv[2], o3 = (f32x4){b[4], b[5], b[6], b[7]} * rs * gv[3];
        if (m == 0 && lane == 0) o0.x += tadd;
        xr[2 * lane] = o0; xr[2 * lane + 1] = o1; xr[128 + 2 * lane] = o2; xr[128 + 2 * lane + 1] = o3; }
}
constexpr int NPHASE = 20;
__global__ void __launch_bounds__(NWAVES * 64, 2) mega(Args args) {
    extern __shared__ __attribute__((aligned(16))) unsigned char lds[];
    Frame F;
    F.lds = (LAS unsigned char*)lds; F.MISC = (volatile LAS unsigned*)(F.lds + MISC_OFF);
    F.tid = threadIdx.x; F.lane = F.tid & 63; F.wave = __builtin_amdgcn_readfirstlane(F.tid >> 6);
    F.G = gridDim.x; { const int bx = blockIdx.x; F.vcu = (F.G % 8 == 0) ? (bx % 8) * (F.G / 8) + bx / 8 : bx; }
    unsigned char* ws = args.ws;
    F.ctl = (gu32*)(ws + WS_CTL);
    for (int u = F.tid; u < (LDS_BYTES - LDSCTL_OFF) / 4; u += NWAVES * 64) ((LAS unsigned*)(F.lds + LDSCTL_OFF))[u] = 0u;
    __syncthreads();
    XcdBarrier bar = xcd_barrier_post((unsigned*)(F.ctl + CW_BAR) + args.li * XCD_BAR_WORDS, F.MISC + 8);
    const int lo = args.ph_lo, hi = args.ph_hi;
#ifndef PHASES
#define PHASES 0xFFFFFu
#endif
#define IN(k) (((PHASES >> (k)) & 1u) && lo <= (k) && (k) < hi)
#ifndef DUP_MASK
#define DUP_MASK 0u
#endif
#define DUP(k) for (int rep_ = 0; rep_ < ((((DUP_MASK) >> (k)) & 1u) ? 2 : 1); ++rep_, (((((DUP_MASK) >> (k)) & 1u) && rep_ == 1) ? xcd_barrier(bar) : (void)0))
#ifdef TPROBE_LO
#define STAMP(k) do { if (blockIdx.x == 0 && F.tid == 0) TS[k] = __builtin_amdgcn_s_memrealtime(); } while (0)
#else
#define STAMP(k) do { } while (0)
#endif
#define SEAM(k) do { if (IN(k) && IN((k) + 1)) xcd_barrier(bar); STAMP((k) + 1); } while (0)
    bf16_t* const WB = (bf16_t*)(ws + WS_WB);
    bf16_t* const XB = (bf16_t*)(ws + WS_XB); bf16_t* const Z = (bf16_t*)(ws + WS_Z); bf16_t* const YMIX = (bf16_t*)(ws + WS_YMIX);
    float* const SSQ = (float*)(ws + WS_SSQ); float* const SSQ2 = (float*)(ws + WS_SSQ2);
    const int bid = (int)blockIdx.x;
#ifndef FUSE_FINAL
#define FUSE_FINAL 0
#endif
    const bool fuse_final = FUSE_FINAL && (F.G == 256) && IN(18) && IN(19);
    unsigned long long* const TS = (unsigned long long*)(ws + WS_CTL + 512 * 1024); (void)TS;
    STAMP(0);

    if (IN(0)) { DUP(0) p0_prologue(F, args); SEAM(0); }
    if (IN(1)) { DUP(1) {
        { pg8::Gemm g{XB, WB + WB_EVIN, MTOK, 2048, 1024, 1024}; pg8::StaticOrder S; S.init(MTOK, 2048, F.G, bid);
          pg8::EpiScaleBf16 E{Z, 2048, SSQ, 0, 16, 1.f / 1024.f, 0, 0};
          pg8::gemm_phase<pg8::EpiScaleBf16, pg8::StaticOrder, true, true>(F.lds + RING_OFF, g, S, E); }
        }
#ifdef ABL_P1
        { pg8::Gemm g{XB, WB + WB_EVIN, MTOK, 2048, 1024, 1024}; pg8::StaticOrder S; S.init(MTOK, 2048, F.G, bid);
#if ABL_P1 == 1
          pg8::EpiNull E{};
          pg8::gemm_phase<pg8::EpiNull, pg8::StaticOrder, true, true>(F.lds + RING_OFF, g, S, E);
#else
          pg8::EpiScaleBf16 E{Z, 2048, SSQ, 0, 16, 1.f / 1024.f, 0, 0, ABL_P1 == 3};
          pg8::gemm_phase<pg8::EpiScaleBf16, pg8::StaticOrder, true, true>(F.lds + RING_OFF, g, S, E);
#endif
        }
#endif
        SEAM(1);
    }

    if (IN(2)) { DUP(2) evenmix_phase(F, args); SEAM(2); }
    if (IN(3)) { pg8::Gemm g{YMIX, WB + WB_EVOUT, MTOK, 1024, 1024, 1024}; pg8::StaticOrder S; S.init(MTOK, 1024, F.G, bid);
        pg8::EpiResid E{XB, SSQ};
        pg8::gemm_phase<pg8::EpiResid, pg8::StaticOrder, true, true>(F.lds + RING_OFF, g, S, E); SEAM(3); }
#pragma unroll 1
    for (int l = 0; l < 2; ++l) {
        const int pb = l ? 14 : 4;
        if (IN(pb)) { DUP(pb) { pg8::Gemm g{XB, WB + (l ? WB_Q1 : WB_Q0), MTOK, 512, 1024, 1024}; pg8::StaticOrder S; S.init(MTOK, 512, F.G, bid);
            pg8::EpiScaleBf16 E{Z, 512, SSQ, 0, 16, 1.f / 1024.f, 0, 0};
            pg8::gemm_phase<pg8::EpiScaleBf16, pg8::StaticOrder, true, true>(F.lds + RING_OFF, g, S, E);
            { pg8::Gemm g2{(const bf16_t*)(ws + WS_MEMN), WB + WB_KV + (size_t)l * 1024 * 1024, BATCH * NMEM, 1024, 1024, 1024}; pg8::StaticOrder S2; S2.init(BATCH * NMEM, 1024, F.G, bid >= 128 ? bid - 128 : 1 << 20);
              pg8::EpiScaleBf16 E2{(bf16_t*)(ws + WS_MEMKV) + (size_t)l * 1024 * 1024, 1024, nullptr, 0, 0, 0.f, 0, 0};
              pg8::gemm_phase<pg8::EpiScaleBf16, pg8::StaticOrder, true, true>(F.lds + RING_OFF, g2, S2, E2); }
            if (bid >= 144 && rep_ == 0) { int t_ = threadIdx.x; asm volatile("" : "+v"(t_)); const int wv_ = __builtin_amdgcn_readfirstlane(t_ >> 6);
                p0_convert(args, (LAS float*)(F.lds + RING_OFF + wv_ * 16640), l == 0 ? NMATS_EARLY : NMATS_MID, l == 0 ? NMATS_MID : NMATS, (bid - 144) * NWAVES + wv_, (F.G - 144) * NWAVES, t_ & 63); }
            } SEAM(pb); }
        if (IN(pb + 1)) { DUP(pb + 1) xattn_phase(F, args, l); SEAM(pb + 1); }
        if (IN(pb + 2)) { pg8::Gemm g{Z + (size_t)MTOK * 512, WB + (l ? WB_O1 : WB_O0), MTOK, 1024, 512, 512}; pg8::StaticOrder S; S.init(MTOK, 1024, F.G, bid);
            pg8::EpiResid E{XB, SSQ};
            pg8::gemm_phase<pg8::EpiResid, pg8::StaticOrder, true, true>(F.lds + RING_OFF, g, S, E); SEAM(pb + 2); }
        if (IN(pb + 3)) { DUP(pb + 3) { pg8::Gemm g{XB, WB + (l ? WB_GU1 : WB_GU0), MTOK, 5632, 1024, 1024}; pg8::StaticOrder S; S.init(MTOK, 5632, F.G, bid);
            pg8::EpiSwiglu E{Z, SSQ};
            pg8::gemm_phase<pg8::EpiSwiglu, pg8::StaticOrder, true, true>(F.lds + RING_OFF, g, S, E); } SEAM(pb + 3); }
        if (IN(pb + 4)) { pg8::Gemm g{Z, WB + (l ? WB_DN1 : WB_DN0), MTOK, 1024, 2816, 2816}; pg8::StaticOrder S; S.init(MTOK, 1024, F.G, bid);
            if (l == 1 && fuse_final) {
                pg8::EpiFinal E{XB, SSQ, args.out, args.in[25], (unsigned*)(F.ctl + CW_FIN)};
                pg8::gemm_phase<pg8::EpiFinal, pg8::StaticOrder, true, true>(F.lds + RING_OFF, g, S, E); }
            else { pg8::EpiResid E{XB, SSQ};
                pg8::gemm_phase<pg8::EpiResid, pg8::StaticOrder, true, true>(F.lds + RING_OFF, g, S, E); }
            SEAM(pb + 4); }
        if (l == 0) {
            if (IN(9)) { DUP(9) { pg8::Gemm g{XB, WB + WB_ODIN, MTOK, 2816, 1024, 1024}; pg8::StaticOrder S; S.init(MTOK, 2816, F.G, bid);
                pg8::EpiZ1 E{Z, SSQ, SSQ2, (float*)(ws + WS_GATES), args.in[18]};
                pg8::gemm_phase<pg8::EpiZ1, pg8::StaticOrder, true, true>(F.lds + RING_OFF, g, S, E); } SEAM(9); }
            if (IN(10)) { DUP(10) {
                mlstm_phase<0>(F, args, F.vcu, F.G);
                bf16_t* QM = (bf16_t*)args.out; bf16_t* KM = QM + (size_t)MTOK * 768; bf16_t* VM = KM + (size_t)MTOK * 768; const float* ROPE = (const float*)(ws + WS_ROPE);
                { pg8::Gemm g{Z + 2048, WB + WB_UQ, MTOK, 768, 384, 2816}; pg8::StaticOrder S; S.init(MTOK, 768, F.G, bid);
                  pg8::EpiMlaQ E{QM, SSQ2, ROPE};
                  pg8::gemm_phase<pg8::EpiMlaQ, pg8::StaticOrder, true, true>(F.lds + RING_OFF, g, S, E); }
                { pg8::Gemm g{Z + 2560, WB + WB_UKV, MTOK, 1024, 256, 2816}; pg8::StaticOrder S; S.init(MTOK, 1024, F.G, bid);
                  pg8::EpiMlaKV E{KM, VM, Z, SSQ2, ROPE};
                  pg8::gemm_phase<pg8::EpiMlaKV, pg8::StaticOrder, true, true>(F.lds + RING_OFF, g, S, E); }
                } SEAM(10); }
            if (IN(11)) { DUP(11) { mlstm_phase<1>(F, args, F.vcu, F.G); mla_attn_phase<0>(F, args, YMIX + 512, 1024); }
#ifdef ABL_MLA
                mla_attn_phase<ABL_MLA>(F, args, (bf16_t*)(ws + WS_EXT + 2 * MiB), 512);
#endif
                SEAM(11); }
            if (IN(13)) { pg8::Gemm g{YMIX, WB + WB_ODOUT, MTOK, 1024, 1024, 1024}; pg8::StaticOrder S; S.init(MTOK, 1024, F.G, bid);
                pg8::EpiResid E{XB, SSQ};
                pg8::gemm_phase<pg8::EpiResid, pg8::StaticOrder, true, true>(F.lds + RING_OFF, g, S, E); SEAM(13); }
        }
    }
    if (IN(19) && !fuse_final) final_norm_phase(F, args, 1.f, 0.f);
#ifdef TPROBE_LO
    xcd_barrier(bar); STAMP(20);
    if (blockIdx.x == 0 && F.tid == 0) { __builtin_amdgcn_s_waitcnt(0); args.out[0] += (float)(long long)(TS[TPROBE_HI] - TS[TPROBE_LO]) * 0.01f * TPROBE_SCALE; }
#endif
#undef IN
#undef SEAM
}
struct In {
    const float *x, *mem; const int* pos; const float *norm_mix_g, *norm_xattn_g, *mem_norm_g, *xattn_wq, *xattn_wkv, *xattn_wo, *norm_ffn_g, *ffn_gu, *ffn_down,
        *ev_w_in, *ev_conv_w, *ev_pool_w, *ev_pool_scale, *ev_w_out, *od_w_in, *od_gate_bias, *od_ml_norm_g, *od_q_norm_g, *od_kv_norm_g, *od_w_uq, *od_w_ukv, *od_w_out, *final_norm_g;
};
#ifndef FASTMASK
#define FASTMASK 0xFFFFFu
#endif
static inline bool isfast(int k) { return (FASTMASK >> k) & 1u; }
static void naive_xb(float* X, unsigned char* ws, hipStream_t st) { nv::xb_ssq<<<MTOK / 4, 256, 0, st>>>(X, (bf16_t*)(ws + WS_XB), (float*)(ws + WS_SSQ)); }
static void naive_xattn_ffn(const In& I, int l, float* X, unsigned char* ws, hipStream_t st, int k, int s0) {
    bf16_t* XB = (bf16_t*)(ws + WS_XB); bf16_t* QX = (bf16_t*)(ws + WS_Z); bf16_t* OX = (bf16_t*)(ws + WS_Z + 16 * MiB); bf16_t* HB = (bf16_t*)(ws + WS_Z);
    const bf16_t* MKV = (const bf16_t*)(ws + WS_MEMKV) + (size_t)l * 1024 * 1024;
    if (k == s0) {
        nv::rmsnorm<float, bf16_t><<<MTOK / 4, 256, 0, st>>>(X, DM, I.norm_xattn_g + l * DM, XB, DM, MTOK, DM);
        nv::gemm<0><<<dim3(512 / 64, MTOK / 64), 256, 0, st>>>(XB, DM, I.xattn_wq + (size_t)l * DM * 512, 512, MTOK, 512, DM, QX, 512, nullptr, 0); }
    if (k == s0 + 1) nv::attn<0, 128, 128><<<MTOK * 4 / 4, 256, 0, st>>>(QX, 512, MKV, 1024, MKV + 512, 1024, OX, 512, SEQ, NMEM, 4, 0, 0.08838834764831845f, nullptr, nullptr, nullptr, 0, nullptr);
    if (k == s0 + 2) nv::gemm<1><<<dim3(DM / 64, MTOK / 64), 256, 0, st>>>(OX, 512, I.xattn_wo + (size_t)l * 512 * DM, DM, MTOK, DM, 512, X, DM, X, 0);
    if (k == s0 + 3) {
        nv::rmsnorm<float, bf16_t><<<MTOK / 4, 256, 0, st>>>(X, DM, I.norm_ffn_g + l * DM, XB, DM, MTOK, DM);
        nv::gemm<2><<<dim3(FFH / 64, MTOK / 64), 256, 0, st>>>(XB, DM, I.ffn_gu + (size_t)l * DM * 2 * FFH, 2 * FFH, MTOK, FFH, DM, HB, FFH, nullptr, FFH); }
    if (k == s0 + 4) nv::gemm<1><<<dim3(DM / 64, MTOK / 64), 256, 0, st>>>(HB, FFH, I.ffn_down + (size_t)l * FFH * DM, DM, MTOK, DM, FFH, X, DM, X, 0);
}
static void naive_stage(const In& I, float* X, unsigned char* ws, hipStream_t st, int k) {
    bf16_t* XB = (bf16_t*)(ws + WS_XB); bf16_t* Z = (bf16_t*)(ws + WS_Z); bf16_t* YMIX = (bf16_t*)(ws + WS_YMIX);
    bf16_t* MEMN = (bf16_t*)(ws + WS_MEMN); bf16_t* MKV = (bf16_t*)(ws + WS_MEMKV);
    float* GATES = (float*)(ws + WS_GATES); float* FCUM = (float*)(ws + WS_FCUM);
    if (k == 1) {
        for (int l = 0; l < 2; ++l) {
            nv::rmsnorm<float, bf16_t><<<1024 / 4, 256, 0, st>>>(I.mem, DM, I.mem_norm_g + l * DM, MEMN, DM, 1024, DM);
            nv::gemm<0><<<dim3(1024 / 64, 1024 / 64), 256, 0, st>>>(MEMN, DM, I.xattn_wkv + (size_t)l * DM * 1024, 1024, 1024, 1024, DM, MKV + (size_t)l * 1024 * 1024, 1024, nullptr, 0);
        }
        nv::rmsnorm<float, bf16_t><<<MTOK / 4, 256, 0, st>>>(I.x, DM, I.norm_mix_g, XB, DM, MTOK, DM);
        nv::gemm<0><<<dim3(2048 / 64, MTOK / 64), 256, 0, st>>>(XB, DM, I.ev_w_in, 2048, MTOK, 2048, DM, Z, 2048, nullptr, 0);
    }
    if (k == 2) {
        nv::evenmix_local<<<MTOK * 512 / 256, 256, 0, st>>>(Z, I.ev_conv_w, YMIX, XB  );
        for (int gi = 0; gi < 4; ++gi)
            nv::gemm<3><<<dim3(128 / 64, MTOK / 64), 256, 0, st>>>(XB + gi * 128, 512, I.ev_pool_w + (size_t)gi * 128 * 128, 128, MTOK, 128, 128, YMIX + 512 + gi * 128, DM, I.ev_pool_scale + gi * 128, 0);
    }
    if (k == 3) nv::gemm<1><<<dim3(DM / 64, MTOK / 64), 256, 0, st>>>(YMIX, DM, I.ev_w_out, DM, MTOK, DM, DM, X, DM, I.x, 0);
    naive_xattn_ffn(I, 0, X, ws, st, k, 4);
    bf16_t* Z1 = Z;
    if (k == 9) {
        nv::rmsnorm<float, bf16_t><<<MTOK / 4, 256, 0, st>>>(X, DM, I.norm_mix_g + DM, XB, DM, MTOK, DM);
        nv::gemm<0><<<dim3(2048 / 64, MTOK / 64), 256, 0, st>>>(XB, DM, I.od_w_in, ODD_IN, MTOK, 2048, DM, Z1, 2816, nullptr, 0);
        nv::gemm<4><<<dim3(1, MTOK / 64), 256, 0, st>>>(XB, DM, I.od_w_in + 2048, ODD_IN, MTOK, 8, DM, GATES, 8, I.od_gate_bias, 0);
        nv::gemm<0><<<dim3(384 / 64, MTOK / 64), 256, 0, st>>>(XB, DM, I.od_w_in + 2056, ODD_IN, MTOK, 384, DM, Z1 + 2048, 2816, nullptr, 0);
        nv::gemm<0><<<dim3(256 / 64, MTOK / 64), 256, 0, st>>>(XB, DM, I.od_w_in + 2440, ODD_IN, MTOK, 256, DM, Z1 + 2560, 2816, nullptr, 0);
        nv::gemm<0><<<dim3(1, MTOK / 64), 256, 0, st>>>(XB, DM, I.od_w_in + 2696, ODD_IN, MTOK, 32, DM, Z1 + 2432, 2816, nullptr, 0);
    }
    if (k == 10) {
        nv::fcum_kernel<<<1, 64, 0, st>>>(GATES, FCUM);
        nv::attn<1, 128, 128><<<MTOK * 4 / 4, 256, 0, st>>>(Z1, 2816, Z1 + 512, 2816, Z1 + 1024, 2816, YMIX, DM, SEQ, SEQ, 4, 1, 0.08838834764831845f, FCUM, GATES, Z1 + 1536, 2816, I.od_ml_norm_g);
    }
    bf16_t* QM = (bf16_t*)(ws + WS_XB); bf16_t* KM = QM + (size_t)MTOK * 768; bf16_t* VM = KM + (size_t)MTOK * 768;
    if (k == 11) {
        bf16_t* S1 = XB; bf16_t* S2 = XB + (size_t)MTOK * 384; bf16_t* KRAW = MEMN; bf16_t* QRAW = Z; bf16_t* KVRAW = Z + (size_t)MTOK * 768;
        nv::rmsnorm<bf16_t, bf16_t><<<MTOK / 4, 256, 0, st>>>(Z1 + 2048, 2816, I.od_q_norm_g, S1, 384, MTOK, 384);
        nv::rmsnorm<bf16_t, bf16_t><<<MTOK / 4, 256, 0, st>>>(Z1 + 2560, 2816, I.od_kv_norm_g, S2, 256, MTOK, 256);
        nv::copy_cols<<<MTOK * 32 / 256, 256, 0, st>>>(Z1 + 2432, 2816, KRAW, 32, MTOK, 32);
        nv::gemm<0><<<dim3(768 / 64, MTOK / 64), 256, 0, st>>>(S1, 384, I.od_w_uq, 768, MTOK, 768, 384, QRAW, 768, nullptr, 0);
        nv::gemm<0><<<dim3(1024 / 64, MTOK / 64), 256, 0, st>>>(S2, 256, I.od_w_ukv, 1024, MTOK, 1024, 256, KVRAW, 1024, nullptr, 0);
        nv::mla_pack<<<MTOK * 768 / 256, 256, 0, st>>>(QRAW, KVRAW, KRAW, 32, I.pos, QM, KM, VM);
    }
    if (k == 12) nv::attn<0, 96, 64><<<MTOK * 8 / 4, 256, 0, st>>>(QM, 768, KM, 768, VM, 512, YMIX + 512, DM, SEQ, SEQ, 8, 1, 0.10206207261596575f, nullptr, nullptr, nullptr, 0, nullptr);
    if (k == 13) nv::gemm<1><<<dim3(DM / 64, MTOK / 64), 256, 0, st>>>(YMIX, DM, I.od_w_out, DM, MTOK, DM, DM, X, DM, X, 0);
    naive_xattn_ffn(I, 1, X, ws, st, k, 14);
    if (k == 19) nv::rmsnorm<float, float><<<MTOK / 4, 256, 0, st>>>(X, DM, I.final_norm_g, X, DM, MTOK, DM);
}
static void fill_mats(Args& a, const In& I, unsigned char* ws) {
    bf16_t* WB = (bf16_t*)(ws + WS_WB); int n = 0;
    auto add = [&](const float* W, const float* gain, size_t dst, int ldw, int K, int Ndst, int map) { a.mats[n].W = W; a.mats[n].gain = gain; a.mats[n].dst = WB + dst; a.mats[n].ldw = ldw; a.mats[n].K = K; a.mats[n].Ndst = Ndst; a.mats[n].map = map; ++n; };
    add(I.ev_w_in, I.norm_mix_g, WB_EVIN, 2048, 1024, 2048, 0);
    add(I.ev_w_out, nullptr, WB_EVOUT, 1024, 1024, 1024, 0);
    for (int gi = 0; gi < 4; ++gi) add(I.ev_pool_w + (size_t)gi * 128 * 128, nullptr, WB_POOL + (size_t)gi * 128 * 128, 128, 128, 128, 0);
    add(I.xattn_wq, I.norm_xattn_g, WB_Q0, 512, 1024, 512, 0);
    add(I.xattn_wo, nullptr, WB_O0, 1024, 512, 1024, 0);
    add(I.ffn_gu, I.norm_ffn_g, WB_GU0, 5632, 1024, 5632, 1);
    add(I.ffn_down, nullptr, WB_DN0, 1024, 2816, 1024, 0);
    add(I.xattn_wkv, I.mem_norm_g, WB_KV, 1024, 1024, 1024, 0);
    add(I.xattn_wq + (size_t)1024 * 512, I.norm_xattn_g + 1024, WB_Q1, 512, 1024, 512, 0);
    add(I.xattn_wo + (size_t)512 * 1024, nullptr, WB_O1, 1024, 512, 1024, 0);
    add(I.xattn_wkv + (size_t)1024 * 1024, I.mem_norm_g + 1024, WB_KV + (size_t)1024 * 1024, 1024, 1024, 1024, 0);
    add(I.od_w_in, I.norm_mix_g + 1024, WB_ODIN, ODD_IN, 1024, 2816, 2);
    add(I.od_w_uq, I.od_q_norm_g, WB_UQ, 768, 384, 768, 0);
    add(I.od_w_ukv, I.od_kv_norm_g, WB_UKV, 1024, 256, 1024, 0);
    add(I.od_w_out, nullptr, WB_ODOUT, 1024, 1024, 1024, 0);
    add(I.ffn_gu + (size_t)1024 * 5632, I.norm_ffn_g + 1024, WB_GU1, 5632, 1024, 5632, 1);
    add(I.ffn_down + (size_t)2816 * 1024, nullptr, WB_DN1, 1024, 2816, 1024, 0);
    if (n != NMATS) fprintf(stderr, "fill_mats: %d matrices, expected %d\n", n, NMATS);
}
extern "C" void kernel_launch(void* const* d_in, const int* in_sizes, int n_in, void* d_out, int out_size, void* d_ws, size_t ws_size, hipStream_t stream) {
    static int grid = 0;
    if (n_in != 26 || out_size != MTOK * DM || ws_size < WS_END) { fprintf(stderr, "kernel_launch: unexpected shapes n_in %d out %d ws %zu\n", n_in, out_size, ws_size); return; }
    In I;
    I.x = (const float*)d_in[0]; I.mem = (const float*)d_in[1]; I.pos = (const int*)d_in[2]; I.norm_mix_g = (const float*)d_in[3]; I.norm_xattn_g = (const float*)d_in[4];
    I.mem_norm_g = (const float*)d_in[5]; I.xattn_wq = (const float*)d_in[6]; I.xattn_wkv = (const float*)d_in[7]; I.xattn_wo = (const float*)d_in[8]; I.norm_ffn_g = (const float*)d_in[9];
    I.ffn_gu = (const float*)d_in[10]; I.ffn_down = (const float*)d_in[11]; I.ev_w_in = (const float*)d_in[12]; I.ev_conv_w = (const float*)d_in[13]; I.ev_pool_w = (const float*)d_in[14];
    I.ev_pool_scale = (const float*)d_in[15]; I.ev_w_out = (const float*)d_in[16]; I.od_w_in = (const float*)d_in[17]; I.od_gate_bias = (const float*)d_in[18]; I.od_ml_norm_g = (const float*)d_in[19];
    I.od_q_norm_g = (const float*)d_in[20]; I.od_kv_norm_g = (const float*)d_in[21]; I.od_w_uq = (const float*)d_in[22]; I.od_w_ukv = (const float*)d_in[23]; I.od_w_out = (const float*)d_in[24];
    I.final_norm_g = (const float*)d_in[25];
    if (grid == 0) {
        int dev = 0, cus = 0, per_cu = 0;
        if (hipGetDevice(&dev) != hipSuccess || hipDeviceGetAttribute(&cus, hipDeviceAttributeMultiprocessorCount, dev) != hipSuccess) { grid = -1; return; }
        if (hipFuncSetAttribute((const void*)mega, hipFuncAttributeMaxDynamicSharedMemorySize, LDS_BYTES) != hipSuccess) { fprintf(stderr, "hipFuncSetAttribute failed\n"); grid = -1; return; }
        if (hipOccupancyMaxActiveBlocksPerMultiprocessor(&per_cu, (const void*)mega, NWAVES * 64, LDS_BYTES) != hipSuccess || per_cu < 1) { fprintf(stderr, "occupancy query: %d\n", per_cu); (void)hipGetLastError(); per_cu = 1; }
        grid = cus;
    }
    if (grid < 0) return;
    (void)hipMemsetAsync((char*)d_ws + WS_CTL + CW_BAR * 4, 0, (2 * XCD_BAR_WORDS + 64 * 64) * 4, stream);
    Args a{};
    for (int i = 0; i < 26; ++i) a.in[i] = (const float*)d_in[i];
    a.out = (float*)d_out; a.ws = (unsigned char*)d_ws; fill_mats(a, I, (unsigned char*)d_ws);
    int li = 0;
    for (int k = 0; k < NPHASE; ) {
        if (isfast(k)) { int k2 = k; while (k2 < NPHASE && isfast(k2)) ++k2;
            a.ph_lo = k; a.ph_hi = k2; a.li = li++;
            hipLaunchKernelGGL(mega, dim3(grid), dim3(NWAVES * 64), LDS_BYTES, stream, a); k = k2; }
        else { naive_stage(I, (float*)d_out, (unsigned char*)d_ws, stream, k);
            if (k == 3 || k == 6 || k == 8 || k == 13 || k == 16 || k == 18) naive_xb((float*)d_out, (unsigned char*)d_ws, stream);
            ++k; }
    }
}
```

```cpp
#include <hip/hip_runtime.h>
#include <cstdio>
#include <cstdint>
#include <cmath>
typedef unsigned short bf16_t;
constexpr int BATCH = 4, SEQ = 4096, DM = 1024, MTOK = BATCH * SEQ, NMEM = 256;
constexpr int FFH = 2816, ODD_IN = 2728;
constexpr size_t MiB = 1u << 20;
constexpr size_t WS_CTL = 0;
constexpr size_t WS_SSQ = 1 * MiB;
constexpr size_t WS_GATES = 3 * MiB;
constexpr size_t WS_FCUM = 3 * MiB + 512 * 1024;
constexpr size_t WS_MEMN = 4 * MiB;
constexpr size_t WS_MEMKV = 6 * MiB;
constexpr size_t WS_WB = 10 * MiB;
constexpr size_t WS_Z = 70 * MiB;
constexpr size_t WS_YMIX = 158 * MiB;
constexpr size_t WS_XB = 190 * MiB;
constexpr size_t WS_EXT = 222 * MiB;
constexpr size_t WS_END = 256 * MiB;
namespace nv {
__device__ __forceinline__ float bf2f(bf16_t v) { return __uint_as_float(((unsigned)v) << 16); }
__device__ __forceinline__ bf16_t f2bf(float f) { unsigned u = __float_as_uint(f); return (bf16_t)((u + 0x7fffu + ((u >> 16) & 1u)) >> 16); }
__device__ __forceinline__ float ldf(const float* p) { return *p; }
__device__ __forceinline__ float ldf(const bf16_t* p) { return bf2f(*p); }
__device__ __forceinline__ float wsum(float v) {
#pragma unroll
    for (int o = 1; o < 64; o <<= 1) v += __shfl_xor(v, o);
    return v;
}
__device__ __forceinline__ float wmax(float v) {
#pragma unroll
    for (int o = 1; o < 64; o <<= 1) v = fmaxf(v, __shfl_xor(v, o));
    return v;
}

__global__ void __launch_bounds__(256) copy_f32(const float* a, float* b, size_t n) {
    for (size_t i = (size_t)blockIdx.x * 256 + threadIdx.x; i < n; i += (size_t)gridDim.x * 256) b[i] = a[i];
}

template <typename TIN, typename TOUT>
__global__ void __launch_bounds__(256) rmsnorm(const TIN* x, int ldx, const float* g, TOUT* out, int ldo, int rows, int width) {
    const int row = blockIdx.x * 4 + (threadIdx.x >> 6), lane = threadIdx.x & 63;
    if (row >= rows) return;
    const TIN* xr = x + (size_t)row * ldx;
    float ss = 0.f;
    for (int c = lane; c < width; c += 64) { const float v = ldf(xr + c); ss += v * v; }
    ss = wsum(ss);
    const float rstd = rsqrtf(ss / (float)width + 1e-6f);
    for (int c = lane; c < width; c += 64) {
        const float v = ldf(xr + c) * rstd * g[c];
        if constexpr (sizeof(TOUT) == 2) out[(size_t)row * ldo + c] = f2bf(v); else out[(size_t)row * ldo + c] = v;
    }
}

__global__ void __launch_bounds__(256) xb_ssq(const float* x, bf16_t* xb, float* ssq) {
    const int row = blockIdx.x * 4 + (threadIdx.x >> 6), lane = threadIdx.x & 63; float ss = 0.f;
    for (int c = lane; c < DM; c += 64) { const float v = x[(size_t)row * DM + c]; ss += v * v; xb[(size_t)row * DM + c] = f2bf(v); }
    ss = wsum(ss); if (lane < 16) ssq[(size_t)row * 16 + lane] = lane == 0 ? ss : 0.f;
}
template <int EPI>
__global__ void __launch_bounds__(256) gemm(const bf16_t* A, int lda, const float* W, int ldw, int M, int N, int K, void* Cv, int ldc, const float* aux, int w2off) {
    __shared__ float As[16][64];
    __shared__ float Ws[16][64];
    __shared__ float Ws2[16][64];
    const int tx = threadIdx.x & 15, ty = threadIdx.x >> 4;
    const int m0 = blockIdx.y * 64, n0 = blockIdx.x * 64;
    float acc[4][4], acc2[4][4];
#pragma unroll
    for (int i = 0; i < 4; ++i)
#pragma unroll
        for (int j = 0; j < 4; ++j) { acc[i][j] = 0.f; acc2[i][j] = 0.f; }
    for (int k0 = 0; k0 < K; k0 += 16) {
#pragma unroll
        for (int i = 0; i < 4; ++i) {
            const int idx = threadIdx.x + i * 256;
            { const int r = idx >> 4, kk = idx & 15; As[kk][r] = bf2f(A[(size_t)(m0 + r) * lda + k0 + kk]); }
            { const int kk = idx >> 6, c = idx & 63;
              Ws[kk][c] = (n0 + c < N) ? W[(size_t)(k0 + kk) * ldw + n0 + c] : 0.f;
              if (EPI == 2) Ws2[kk][c] = (n0 + c < N) ? W[(size_t)(k0 + kk) * ldw + w2off + n0 + c] : 0.f; }
        }
        __syncthreads();
#pragma unroll
        for (int kk = 0; kk < 16; ++kk) {
            float a[4], b[4], b2[4];
#pragma unroll
            for (int i = 0; i < 4; ++i) { a[i] = As[kk][ty * 4 + i]; b[i] = Ws[kk][tx * 4 + i]; b2[i] = (EPI == 2) ? Ws2[kk][tx * 4 + i] : 0.f; }
#pragma unroll
            for (int i = 0; i < 4; ++i)
#pragma unroll
                for (int j = 0; j < 4; ++j) { acc[i][j] += a[i] * b[j]; if (EPI == 2) acc2[i][j] += a[i] * b2[j]; }
        }
        __syncthreads();
    }
#pragma unroll
    for (int i = 0; i < 4; ++i)
#pragma unroll
        for (int j = 0; j < 4; ++j) {
            const int row = m0 + ty * 4 + i, col = n0 + tx * 4 + j;
            if (col >= N) continue;
            const float v = acc[i][j];
            if (EPI == 0) ((bf16_t*)Cv)[(size_t)row * ldc + col] = f2bf(v);
            if (EPI == 1) ((float*)Cv)[(size_t)row * ldc + col] = aux[(size_t)row * ldc + col] + v;
            if (EPI == 2) { const float u = acc2[i][j]; ((bf16_t*)Cv)[(size_t)row * ldc + col] = f2bf(v / (1.f + __expf(-v)) * u); }
            if (EPI == 3) ((bf16_t*)Cv)[(size_t)row * ldc + col] = f2bf(v * aux[col]);
            if (EPI == 4) ((float*)Cv)[(size_t)row * ldc + col] = v + aux[col];
        }
}

__global__ void __launch_bounds__(256) evenmix_local(const bf16_t* z, const float* conv_w, bf16_t* ymix, bf16_t* dscr) {
    const size_t idx = (size_t)blockIdx.x * 256 + threadIdx.x;
    const int c = (int)(idx & 511); const int row = (int)(idx >> 9); const int tt = row & (SEQ - 1);
    const bf16_t* zr = z + (size_t)row * 2048;
    float acc = 0.f;
#pragma unroll
    for (int k = 0; k < 3; ++k) { const int d = 2 - k; if (tt - d >= 0) { const bf16_t* zp = zr - (size_t)d * 2048; acc += conv_w[k * 512 + c] * (bf2f(zp[512 + c]) * bf2f(zp[1024 + c])); } }
    ymix[(size_t)row * 1024 + c] = f2bf(bf2f(zr[c]) * acc);
    const int gi = c >> 7, w = 2 << gi; const int cnt = (tt + 1 < w) ? tt + 1 : w;
    float s = 0.f;
    for (int j = 0; j < cnt; ++j) s += bf2f((zr - (size_t)j * 2048)[1536 + c]);
    dscr[(size_t)row * 512 + c] = f2bf(s / (float)cnt - bf2f(zr[1536 + c]));
}

__global__ void fcum_kernel(const float* gates, float* fcum) {
    const int id = blockIdx.x * blockDim.x + threadIdx.x; if (id >= BATCH * 4) return;
    const int b = id >> 2, h = id & 3; float s = 0.f;
    for (int t = 0; t < SEQ; ++t) { const size_t row = (size_t)b * SEQ + t; const float f = gates[row * 8 + 4 + h];
        const float ls = fminf(f, 0.f) - log1pf(__expf(-fabsf(f))); s += ls; fcum[row * 4 + h] = s; }
}

__global__ void __launch_bounds__(256) copy_cols(const bf16_t* src, int lds_, bf16_t* dst, int ldd, int rows, int cols) {
    const size_t idx = (size_t)blockIdx.x * 256 + threadIdx.x; if (idx >= (size_t)rows * cols) return;
    const size_t r = idx / cols; const int c = (int)(idx % cols); dst[r * ldd + c] = src[r * lds_ + c];
}
__global__ void __launch_bounds__(256) mla_pack(const bf16_t* qraw, const bf16_t* kvraw, const bf16_t* kr, int ldkr, const int* positions, bf16_t* QM, bf16_t* KM, bf16_t* VM) {
    const size_t idx = (size_t)blockIdx.x * 256 + threadIdx.x;
    const int col = (int)(idx % 768); const size_t row = idx / 768;
    const int h = col / 96, j = col % 96;
    const float pos = (float)positions[row];
    if (j < 64) { QM[row * 768 + col] = qraw[row * 768 + col]; KM[row * 768 + col] = kvraw[row * 1024 + h * 128 + j]; VM[row * 512 + h * 64 + j] = kvraw[row * 1024 + h * 128 + 64 + j]; }
    else {
        const int r = j - 64, i = r & 15;
        const float inv = powf(10000.0f, -(float)i / 16.0f); const float ang = pos * inv; const float cs = cosf(ang), sn = sinf(ang);
        { const float t1 = bf2f(qraw[row * 768 + h * 96 + 64 + i]), t2 = bf2f(qraw[row * 768 + h * 96 + 80 + i]); QM[row * 768 + col] = f2bf(r < 16 ? t1 * cs - t2 * sn : t1 * sn + t2 * cs); }
        { const float t1 = bf2f(kr[row * ldkr + i]), t2 = bf2f(kr[row * ldkr + 16 + i]); KM[row * 768 + col] = f2bf(r < 16 ? t1 * cs - t2 * sn : t1 * sn + t2 * cs); }
    }
}

template <int MODE, int DK, int DV>
__global__ void __launch_bounds__(256) attn(const bf16_t* Q, int ldq, const bf16_t* Kp, int ldk, const bf16_t* Vp, int ldv, bf16_t* O, int ldo,
                                            int Sq, int Sk, int H, int causal, float scale, const float* fcum, const float* gates, const bf16_t* ogate, int ldg, const float* normg) {
    __shared__ float qs[4][DK];
    const int wv = threadIdx.x >> 6, lane = threadIdx.x & 63;
    const size_t w = (size_t)blockIdx.x * 4 + wv;
    const int t = (int)(w % Sq); const int h = (int)((w / Sq) % H); const int b = (int)(w / ((size_t)Sq * H));
    const size_t qrow = (size_t)b * Sq + t;
    for (int d = lane; d < DK; d += 64) qs[wv][d] = bf2f(Q[qrow * ldq + h * DK + d]);
    __syncthreads();
    const int nk = causal ? t + 1 : Sk;
    float m = -INFINITY, l = 0.f; float acc[(DV + 63) / 64];
#pragma unroll
    for (int i = 0; i < (DV + 63) / 64; ++i) acc[i] = 0.f;
    const float Ft = (MODE == 1) ? fcum[qrow * 4 + h] : 0.f;
    for (int s0 = 0; s0 < nk; s0 += 64) {
        const int s = s0 + lane; const bool ok = s < nk; const size_t krow = (size_t)b * Sk + (ok ? s : 0);
        float sc = 0.f;
        const bf16_t* kr = Kp + krow * ldk + h * DK;
        for (int d = 0; d < DK; ++d) sc += qs[wv][d] * bf2f(kr[d]);
        sc *= scale;
        float a;
        if (MODE == 1) a = ok ? (Ft - fcum[krow * 4 + h] + gates[krow * 8 + h]) : -INFINITY; else a = ok ? sc : -INFINITY;
        const float mb = wmax(a); const float mn = fmaxf(m, mb);
        const float f = __expf(m - mn);
        float p = ok ? __expf(a - mn) : 0.f; if (MODE == 1) p *= sc;
        l = l * f + wsum(p);
#pragma unroll
        for (int i = 0; i < (DV + 63) / 64; ++i) acc[i] *= f;
        const int cntk = (nk - s0 < 64) ? nk - s0 : 64;
        for (int j = 0; j < cntk; ++j) {
            const float pj = __shfl(p, j); const bf16_t* vr = Vp + ((size_t)b * Sk + s0 + j) * ldv + h * DV;
#pragma unroll
            for (int i = 0; i < (DV + 63) / 64; ++i) { const int d = lane + 64 * i; if (d < DV) acc[i] += pj * bf2f(vr[d]); }
        }
        m = mn;
    }
    if (MODE == 0) {
#pragma unroll
        for (int i = 0; i < (DV + 63) / 64; ++i) { const int d = lane + 64 * i; if (d < DV) O[qrow * ldo + h * DV + d] = f2bf(acc[i] / l); }
    } else {
        const float den = fmaxf(fabsf(l), __expf(-m)); float hv[(DV + 63) / 64]; float ss = 0.f;
#pragma unroll
        for (int i = 0; i < (DV + 63) / 64; ++i) { const int d = lane + 64 * i; const float og = bf2f(ogate[qrow * ldg + h * DV + d]);
            hv[i] = (acc[i] / den) / (1.f + __expf(-og)); ss += hv[i] * hv[i]; }
        ss = wsum(ss); const float rstd = rsqrtf(ss / (float)DV + 1e-6f);
#pragma unroll
        for (int i = 0; i < (DV + 63) / 64; ++i) { const int d = lane + 64 * i; O[qrow * ldo + h * DV + d] = f2bf(hv[i] * rstd * normg[h * DV + d]); }
    }
}
}
namespace pg8 {
#define PG8_LAS __attribute__((address_space(3)))
typedef unsigned short bf16_t;
typedef short bf16x8 __attribute__((ext_vector_type(8)));
typedef float f32x4 __attribute__((ext_vector_type(4)));
typedef unsigned u32x4 __attribute__((ext_vector_type(4)));
constexpr int BM = 256, BK = 64, HALF = 128, HTB = HALF * BK * 2  , STAGE_BYTES = 8 * HTB, NXCD = 8, WGM = 8;

__host__ __device__ __forceinline__ int lds_byte(int r, int c) { const int st = (r >> 4) * 2 + (c >> 5), rr = r & 15, cc = c & 31, ob = rr * 64 + cc * 2; return st * 1024 + (ob ^ (((ob >> 9) & 1) << 5)); }
__host__ __device__ __forceinline__ void stage_rc(int b, int& R, int& C) { const int st = b / 1024, sb = b % 1024, swz = sb ^ (((sb >> 9) & 1) << 5); R = (st >> 1) * 16 + swz / 64; C = (st & 1) * 32 + (swz % 64) / 2; }
__host__ __device__ __forceinline__ int perm32(int rho) { const int n = rho >> 4, i = rho & 15; return 8 * (i >> 2) + 4 * n + (i & 3); }

struct Unit { int pm, pn, h; };
struct Gemm { const bf16_t* A; const bf16_t* Bt; int M, N, K, lda; };

struct StaticOrder {
    int nM, nN, nwg, G, c, lim;
    __host__ __device__ void init(int M, int N, int G_, int c_) { nM = M / BM; nN = N / BM; nwg = nM * nN; G = G_; c = c_; lim = nwg; }
    __host__ __device__ __forceinline__ void map(int wgid, Unit& u) const {
        { const int q = nwg / NXCD, r = nwg % NXCD, xcd = wgid % NXCD, off = wgid / NXCD; wgid = (xcd < r ? xcd * (q + 1) : r * (q + 1) + (xcd - r) * q) + off; }
        const int nig = WGM * nN, gid = wgid / nig, fm = gid * WGM, gsz = (nM - fm) < WGM ? (nM - fm) : WGM;
        u.pm = fm + ((wgid % nig) % gsz); u.pn = (wgid % nig) / gsz; u.h = 0;
    }
    __host__ __device__ __forceinline__ bool next(int i, Unit& u) const {
        const long L = (long)i * G + c; if (L >= lim) return false;
        map((int)L, u); return true;
    }
    __device__ __forceinline__ void a_ready(const Unit&) const {}
    __device__ __forceinline__ void done(const Unit&) const {}
};

struct TailOrder {
    StaticOrder base; int first, cnt;
    __device__ __forceinline__ bool next(int i, Unit& u) const { if (i > 0 || base.c >= 2 * cnt) return false; base.map(first + base.c % cnt, u); u.h = base.c / cnt; return true; }
    __device__ __forceinline__ void a_ready(const Unit&) const {}
    __device__ __forceinline__ void done(const Unit&) const {}
};

__device__ __forceinline__ unsigned cvt_pk_bf16(float lo, float hi) { unsigned r; asm volatile("v_cvt_pk_bf16_f32 %0, %1, %2" : "=v"(r) : "v"(lo), "v"(hi)); return r; }
typedef float f32x2 __attribute__((ext_vector_type(2)));

__device__ __forceinline__ unsigned pkbf(float lo, float hi) { f32x2 v = {lo, hi}; typedef __bf16 bf2 __attribute__((ext_vector_type(2))); bf2 b = __builtin_convertvector(v, bf2); return __builtin_bit_cast(unsigned, b); }
__device__ __forceinline__ u32x4 pack8(const f32x4 a, const f32x4 b) { u32x4 w; w.x = pkbf(a[0], a[1]); w.y = pkbf(a[2], a[3]); w.z = pkbf(b[0], b[1]); w.w = pkbf(b[2], b[3]); return w; }

__device__ __forceinline__ __amdgpu_buffer_rsrc_t mk_rsrc(const void* p) { return __builtin_amdgcn_make_buffer_rsrc((void*)p, 0, 0x7fffffff, 0x00020000); }
__device__ __forceinline__ void st16_wt(__amdgpu_buffer_rsrc_t r, size_t elem_off_bf16, const u32x4 v) { __builtin_amdgcn_raw_buffer_store_b128(v, r, (int)(unsigned)(elem_off_bf16 * 2), 0, 16); }
__device__ __forceinline__ float row_rstd(const float* ssq, int row, int slot0, int ns, float inv_width, int fq) {
    float s = 0.f;
    if (ssq) { if (4 * fq < ns) { const f32x4 v = *(const f32x4*)(ssq + (size_t)row * 16 + slot0 + 4 * fq); s = (v[0] + v[1]) + (v[2] + v[3]); }
        s += __shfl_xor(s, 16); s += __shfl_xor(s, 32); return rsqrtf(s * inv_width + 1e-6f); }
    return 1.f;
}

__device__ __forceinline__ void rows_rstd(float (&rs)[2][4], const float* ssq, int rowbase, int slot0, int ns, float inv_width, int fq, const PG8_LAS float* rsb = nullptr) {
    if (rsb) {
#pragma unroll
        for (int ai = 0; ai < 2; ++ai)
#pragma unroll
            for (int m = 0; m < 4; ++m) rs[ai][m] = rsb[((rowbase & (BM - 1)) + ai * HALF + m * 16) & (BM - 1)];
        return; }
    if (!ssq) {
#pragma unroll
        for (int ai = 0; ai < 2; ++ai)
#pragma unroll
            for (int m = 0; m < 4; ++m) rs[ai][m] = 1.f;
        return; }
    f32x4 v[2][4];
#pragma unroll
    for (int ai = 0; ai < 2; ++ai)
#pragma unroll
        for (int m = 0; m < 4; ++m) v[ai][m] = *(const f32x4*)(ssq + (size_t)(rowbase + ai * HALF + m * 16) * 16 + slot0 + (4 * fq < ns ? 4 * fq : 0));
    const float okf = (4 * fq < ns) ? 1.f : 0.f;
#pragma unroll
    for (int ai = 0; ai < 2; ++ai)
#pragma unroll
        for (int m = 0; m < 4; ++m) { float s_ = ((v[ai][m][0] + v[ai][m][1]) + (v[ai][m][2] + v[ai][m][3])) * okf; s_ += __shfl_xor(s_, 16); s_ += __shfl_xor(s_, 32); rs[ai][m] = rsqrtf(s_ * inv_width + 1e-6f); }
}
struct EpiScaleBf16 {
    static constexpr bool PERM = true, AFTER_DRAIN = false, RESID_LDS = false, PRE_RSTD = false;
    bf16_t* O; int ldc; const float* ssq; int slot0, ns; float inv_width; int split_cols; size_t split_stride; int nostore = 0;
    __device__ __forceinline__ bool pre_ok() const { return ssq != nullptr && slot0 == 0 && ns == 16; }
    __device__ __forceinline__ void operator()(const f32x4 (&acc)[2][2][4][2], const Unit& u, int wr, int wc, int fr, int fq, const PG8_LAS float* rsb = nullptr) const {
        int colt = u.pn * BM; bf16_t* base = O; if (split_cols) { const int t = colt / split_cols; base += (size_t)t * split_stride; colt -= t * split_cols; }
        const int col0 = colt + wc * 32 + 8 * fq;
        float rsv[2][4]; rows_rstd(rsv, ssq, u.pm * BM + wr * 64 + fr, slot0, ns, inv_width, fq, rsb);
#pragma unroll
        for (int ai = 0; ai < 2; ++ai)
#pragma unroll
            for (int m = 0; m < 4; ++m) { int row = u.pm * BM + ai * HALF + wr * 64 + m * 16 + fr; asm volatile("" : "+v"(row)); const float rs = rsv[ai][m];
#pragma unroll
                for (int bj = 0; bj < 2; ++bj) { const u32x4 w_ = pack8(acc[ai][bj][m][0] * rs, acc[ai][bj][m][1] * rs); if (nostore) asm volatile("" :: "v"(w_)); else *(u32x4*)(base + (size_t)row * ldc + col0 + bj * HALF) = w_; } }
    }
};
struct EpiNull {
    static constexpr bool PERM = true, AFTER_DRAIN = false, RESID_LDS = false, PRE_RSTD = false;
    __device__ __forceinline__ void operator()(const f32x4 (&acc)[2][2][4][2], const Unit& u, int wr, int wc, int fr, int fq) const {
#pragma unroll
        for (int ai = 0; ai < 2; ++ai)
#pragma unroll
            for (int bj = 0; bj < 2; ++bj)
#pragma unroll
                for (int m = 0; m < 4; ++m) asm volatile("" :: "v"(acc[ai][bj][m][0]), "v"(acc[ai][bj][m][1]));
    }
};
struct EpiResid {
    static constexpr bool PERM = true, AFTER_DRAIN = false, RESID_LDS = true, PRE_RSTD = false;
    bf16_t* xb; float* ssq;
    __device__ __forceinline__ void operator()(const f32x4 (&acc)[2][2][4][2], const Unit& u, int wr, int wc, int fr, int fq) const {
        const int col0 = u.pn * BM + wc * 32 + 8 * fq, rowb = u.pm * BM + wr * 64 + fr;
#pragma unroll
        for (int ai = 0; ai < 2; ++ai) { u32x4 bb[4][2];
#pragma unroll
            for (int m = 0; m < 4; ++m)
#pragma unroll
                for (int bj = 0; bj < 2; ++bj) bb[m][bj] = *(const u32x4*)(xb + (size_t)(rowb + ai * HALF + m * 16) * 1024 + col0 + bj * HALF);
#pragma unroll
            for (int m = 0; m < 4; ++m) { int row = rowb + ai * HALF + m * 16; asm volatile("" : "+v"(row)); float ss = 0.f;
#pragma unroll
                for (int bj = 0; bj < 2; ++bj) { const size_t off = (size_t)row * 1024 + col0 + bj * HALF;
                    const u32x4 b = bb[m][bj];
                    f32x4 v0 = acc[ai][bj][m][0], v1 = acc[ai][bj][m][1];
                    v0[0] += __uint_as_float(b.x << 16); v0[1] += __uint_as_float(b.x & 0xffff0000u); v0[2] += __uint_as_float(b.y << 16); v0[3] += __uint_as_float(b.y & 0xffff0000u);
                    v1[0] += __uint_as_float(b.z << 16); v1[1] += __uint_as_float(b.z & 0xffff0000u); v1[2] += __uint_as_float(b.w << 16); v1[3] += __uint_as_float(b.w & 0xffff0000u);
                    *(u32x4*)(xb + off) = pack8(v0, v1);
                    ss += (v0[0] * v0[0] + v0[1] * v0[1]) + (v0[2] * v0[2] + v0[3] * v0[3]) + (v1[0] * v1[0] + v1[1] * v1[1]) + (v1[2] * v1[2] + v1[3] * v1[3]); }
                ss += __shfl_xor(ss, 16); ss += __shfl_xor(ss, 32);
                if (fq == 0) ssq[(size_t)row * 16 + u.pn * 4 + wc] = ss; } }
    }
    static __device__ __forceinline__ unsigned lane_off(int wr, int wc, int fr, int fq) { return (unsigned)(((wr * 64 + fr) * 1024 + wc * 32 + 8 * fq) * 2); }
    static __device__ __forceinline__ constexpr unsigned piece_off(int p) { return (unsigned)((((p >> 3) * HALF + ((p >> 1) & 3) * 16) * 1024 + (p & 1) * HALF) * 2); }
    static __device__ __forceinline__ constexpr unsigned piece_slot(int p) { return (unsigned)(((p >> 1) == 0 ? 4 : (p >> 1) == 1 ? 5 : (p >> 1) == 2 ? 0 : (p >> 1) == 3 ? 1 : (p >> 1) == 4 ? 6 : (p >> 1) == 5 ? 7 : 2) * HTB + (p & 1) * 8192); }
    __device__ __forceinline__ const char* tile_base(const Unit& u) const { return (const char*)(xb + (size_t)u.pm * BM * 1024 + u.pn * BM); }
    __device__ __forceinline__ void lds_epi(const f32x4 (&acc)[2][2][4][2], const Unit& u, int wr, int wc, int fr, int fq, const PG8_LAS unsigned char* lds, int wid, int lane) const {
        const int col0 = u.pn * BM + wc * 32 + 8 * fq, rowb = u.pm * BM + wr * 64 + fr;
        u32x4 gl[2];
#pragma unroll
        for (int bj = 0; bj < 2; ++bj) gl[bj] = *(const u32x4*)(xb + (size_t)(rowb + HALF + 48) * 1024 + col0 + bj * HALF);
        asm volatile("s_waitcnt vmcnt(2)" ::: "memory");
        const PG8_LAS unsigned char* my = lds + wid * 1024 + lane * 16;
#pragma unroll
        for (int ai = 0; ai < 2; ++ai)
#pragma unroll
            for (int m = 0; m < 4; ++m) { int row = rowb + ai * HALF + m * 16; asm volatile("" : "+v"(row)); float ss = 0.f;
#pragma unroll
                for (int bj = 0; bj < 2; ++bj) { const size_t off = (size_t)row * 1024 + col0 + bj * HALF; const int p = ai * 8 + m * 2 + bj;
                    u32x4 b; if (p < 14) b = *(const PG8_LAS u32x4*)(my + piece_slot(p)); else b = gl[bj];
                    f32x4 v0 = acc[ai][bj][m][0], v1 = acc[ai][bj][m][1];
                    v0[0] += __uint_as_float(b.x << 16); v0[1] += __uint_as_float(b.x & 0xffff0000u); v0[2] += __uint_as_float(b.y << 16); v0[3] += __uint_as_float(b.y & 0xffff0000u);
                    v1[0] += __uint_as_float(b.z << 16); v1[1] += __uint_as_float(b.z & 0xffff0000u); v1[2] += __uint_as_float(b.w << 16); v1[3] += __uint_as_float(b.w & 0xffff0000u);
                    *(u32x4*)(xb + off) = pack8(v0, v1);
                    ss += (v0[0] * v0[0] + v0[1] * v0[1]) + (v0[2] * v0[2] + v0[3] * v0[3]) + (v1[0] * v1[0] + v1[1] * v1[1]) + (v1[2] * v1[2] + v1[3] * v1[3]); }
                ss += __shfl_xor(ss, 16); ss += __shfl_xor(ss, 32);
                if (fq == 0) ssq[(size_t)row * 16 + u.pn * 4 + wc] = ss; }
    }
};
struct EpiFinal {
    static constexpr bool PERM = true, AFTER_DRAIN = false, RESID_LDS = false, PRE_RSTD = false;
    const bf16_t* xb; float* ssq; float* out; const float* g; unsigned* cnt;
    __device__ __forceinline__ void operator()(f32x4 (&acc)[2][2][4][2], const Unit& u, int wr, int wc, int fr, int fq) const {
        const int col0 = u.pn * BM + wc * 32 + 8 * fq, rowbase = u.pm * BM + wr * 64 + fr;
#pragma unroll
        for (int ai = 0; ai < 2; ++ai)
#pragma unroll
            for (int m = 0; m < 4; ++m) { int row = rowbase + ai * HALF + m * 16; asm volatile("" : "+v"(row)); float ss = 0.f;
#pragma unroll
                for (int bj = 0; bj < 2; ++bj) { const u32x4 b = *(const u32x4*)(xb + (size_t)row * 1024 + col0 + bj * HALF);
                    f32x4& v0 = acc[ai][bj][m][0]; f32x4& v1 = acc[ai][bj][m][1];
                    v0[0] += __uint_as_float(b.x << 16); v0[1] += __uint_as_float(b.x & 0xffff0000u); v0[2] += __uint_as_float(b.y << 16); v0[3] += __uint_as_float(b.y & 0xffff0000u);
                    v1[0] += __uint_as_float(b.z << 16); v1[1] += __uint_as_float(b.z & 0xffff0000u); v1[2] += __uint_as_float(b.w << 16); v1[3] += __uint_as_float(b.w & 0xffff0000u);
                    ss += (v0[0] * v0[0] + v0[1] * v0[1]) + (v0[2] * v0[2] + v0[3] * v0[3]) + (v1[0] * v1[0] + v1[1] * v1[1]) + (v1[2] * v1[2] + v1[3] * v1[3]); }
                ss += __shfl_xor(ss, 16); ss += __shfl_xor(ss, 32);
                if (fq == 0) __hip_atomic_store(ssq + (size_t)row * 16 + u.pn * 4 + wc, ss, __ATOMIC_RELAXED, __HIP_MEMORY_SCOPE_AGENT); }
        asm volatile("s_waitcnt vmcnt(0)" ::: "memory");
        unsigned* c = cnt + 64 * u.pm;
        if ((threadIdx.x & 63) == 0) __hip_atomic_fetch_add(c, 1u, __ATOMIC_RELAXED, __HIP_MEMORY_SCOPE_AGENT);
        { unsigned spins = 0;
          while ((unsigned)__builtin_amdgcn_readfirstlane(__hip_atomic_load(c, __ATOMIC_RELAXED, __HIP_MEMORY_SCOPE_AGENT)) < 32u) { __builtin_amdgcn_s_sleep(2); if (++spins > (1u << 16)) break; } }
        __builtin_amdgcn_fence(__ATOMIC_ACQUIRE, "agent");
        asm volatile("s_waitcnt vmcnt(0)" ::: "memory");
        float rs[2][4]; rows_rstd(rs, ssq, rowbase, 0, 16, 1.f / 1024.f, fq);
        f32x4 gv[2][2];
#pragma unroll
        for (int bj = 0; bj < 2; ++bj) { gv[bj][0] = *(const f32x4*)(g + col0 + bj * HALF); gv[bj][1] = *(const f32x4*)(g + col0 + bj * HALF + 4); }
#pragma unroll
        for (int ai = 0; ai < 2; ++ai)
#pragma unroll
            for (int m = 0; m < 4; ++m) { int row = rowbase + ai * HALF + m * 16; asm volatile("" : "+v"(row));
#pragma unroll
                for (int bj = 0; bj < 2; ++bj) { float* op = out + (size_t)row * 1024 + col0 + bj * HALF;
                    *(f32x4*)(op) = acc[ai][bj][m][0] * rs[ai][m] * gv[bj][0]; *(f32x4*)(op + 4) = acc[ai][bj][m][1] * rs[ai][m] * gv[bj][1]; } }
    }
};
__device__ __forceinline__ float silu_mul2(float ag, float au, float rsl, float rs2) { return ((ag * au) * rs2) * __builtin_amdgcn_rcpf(1.f + __builtin_amdgcn_exp2f(ag * rsl)); }
__device__ __forceinline__ float silu_mul(float g, float u) { return (g * u) * __builtin_amdgcn_rcpf(1.f + __builtin_amdgcn_exp2f(g * -1.4426950408889634f)); }
struct EpiSwiglu {
    static constexpr bool PERM = true, AFTER_DRAIN = false, RESID_LDS = false, PRE_RSTD = true;
    bf16_t* H; const float* ssq;
    __device__ __forceinline__ bool pre_ok() const { return true; }
    __device__ __forceinline__ void operator()(const f32x4 (&acc)[2][2][4][2], const Unit& u, int wr, int wc, int fr, int fq, const PG8_LAS float* rsb = nullptr) const {
        const int col0 = u.pn * HALF + wc * 32 + 8 * fq;
        float rsv[2][4]; rows_rstd(rsv, ssq, u.pm * BM + wr * 64 + fr, 0, 16, 1.f / 1024.f, fq, rsb);
#pragma unroll
        for (int ai = 0; ai < 2; ++ai)
#pragma unroll
            for (int m = 0; m < 4; ++m) { int row = u.pm * BM + ai * HALF + wr * 64 + m * 16 + fr; asm volatile("" : "+v"(row)); const float rs = rsv[ai][m], rsl = rs * -1.4426950408889634f, rs2 = rs * rs;
                f32x4 h0, h1;
#pragma unroll
                for (int e = 0; e < 4; ++e) { h0[e] = silu_mul2(acc[ai][0][m][0][e], acc[ai][1][m][0][e], rsl, rs2); h1[e] = silu_mul2(acc[ai][0][m][1][e], acc[ai][1][m][1][e], rsl, rs2); }
                *(u32x4*)(H + (size_t)row * 2816 + col0) = pack8(h0, h1); }
    }
    __device__ __forceinline__ void half(const f32x4 (&acc)[2][2][4][2], const Unit& u, int wr, int wc, int fr, int fq, const PG8_LAS float* rsb) const {
        const int col0 = u.pn * HALF + wc * 32 + 8 * fq, rowbase = u.pm * BM + u.h * HALF + wr * 64 + fr;
#pragma unroll
        for (int m = 0; m < 4; ++m) { const float rs = rsb[u.h * HALF + wr * 64 + fr + m * 16], rsl = rs * -1.4426950408889634f, rs2 = rs * rs;
            int row = rowbase + m * 16; asm volatile("" : "+v"(row));
            f32x4 h0, h1;
#pragma unroll
            for (int e = 0; e < 4; ++e) { h0[e] = silu_mul2(acc[0][0][m][0][e], acc[0][1][m][0][e], rsl, rs2); h1[e] = silu_mul2(acc[0][0][m][1][e], acc[0][1][m][1][e], rsl, rs2); }
            *(u32x4*)(H + (size_t)row * 2816 + col0) = pack8(h0, h1); }
    }
};
struct EpiZ1 {
    static constexpr bool PERM = true, AFTER_DRAIN = false, RESID_LDS = false, PRE_RSTD = true;
    bf16_t* Z1; const float* ssq; float* ssq2; float* gates; const float* gate_bias;
    __device__ __forceinline__ bool pre_ok() const { return true; }
    __device__ __forceinline__ void operator()(const f32x4 (&acc)[2][2][4][2], const Unit& u, int wr, int wc, int fr, int fq, const PG8_LAS float* rsb = nullptr) const {
        const int col0 = u.pn * BM + wc * 32 + 8 * fq;
        float rsv[2][4]; rows_rstd(rsv, ssq, u.pm * BM + wr * 64 + fr, 0, 16, 1.f / 1024.f, fq, rsb);
        const f32x4 gb0 = *(const f32x4*)(gate_bias), gb1 = *(const f32x4*)(gate_bias + 4);

#pragma unroll
        for (int ai = 0; ai < 2; ++ai)
#pragma unroll
            for (int m = 0; m < 4; ++m) { int row = u.pm * BM + ai * HALF + wr * 64 + m * 16 + fr; asm volatile("" : "+v"(row)); const float rs = rsv[ai][m];
                float sq[2];
#pragma unroll
                for (int bj = 0; bj < 2; ++bj) { const f32x4 v0 = acc[ai][bj][m][0] * rs, v1 = acc[ai][bj][m][1] * rs;
                    *(u32x4*)(Z1 + (size_t)row * 2816 + col0 + bj * HALF) = pack8(v0, v1);
                    sq[bj] = (v0[0] * v0[0] + v0[1] * v0[1]) + (v0[2] * v0[2] + v0[3] * v0[3]) + (v1[0] * v1[0] + v1[1] * v1[1]) + (v1[2] * v1[2] + v1[3] * v1[3]); }
                if (u.pn >= 8) { float s = (u.pn == 9) ? sq[0] : sq[0] + sq[1]; s += __shfl_xor(s, 16); s += __shfl_xor(s, 32);
                    if (fq == 0) ssq2[(size_t)row * 16 + (u.pn == 10 ? 8 : (u.pn - 8) * 4) + wc] = s; }
                if (u.pn == 9 && wc == 1 && fq == 0) { const f32x4 gi = acc[ai][1][m][0] * rs + gb0, gf = acc[ai][1][m][1] * rs + gb1;
                    *(f32x4*)(gates + (size_t)row * 8) = gi; *(f32x4*)(gates + (size_t)row * 8 + 4) = gf; } }
    }
};
struct RopeTab { f32x4 c0, c1, s0, s1; };
__device__ __forceinline__ RopeTab rope_load(const float* rope, int row, int fq) { const float* rp = rope + (size_t)row * 32 + 8 * (fq & 1);
    RopeTab t; t.c0 = *(const f32x4*)(rp); t.c1 = *(const f32x4*)(rp + 4); t.s0 = *(const f32x4*)(rp + 16); t.s1 = *(const f32x4*)(rp + 20); return t; }
__device__ __forceinline__ void rope8(f32x4& v0, f32x4& v1, const RopeTab& t, int fq) {
    f32x4 o0, o1;
#pragma unroll
    for (int e = 0; e < 4; ++e) { auto r0 = __builtin_amdgcn_permlane32_swap(__float_as_uint(v0[e]), __float_as_uint(v0[e]), false, false); o0[e] = __uint_as_float(fq < 2 ? r0[1] : r0[0]);
        auto r1 = __builtin_amdgcn_permlane32_swap(__float_as_uint(v1[e]), __float_as_uint(v1[e]), false, false); o1[e] = __uint_as_float(fq < 2 ? r1[1] : r1[0]); }
    if (fq < 2) { v0 = v0 * t.c0 - o0 * t.s0; v1 = v1 * t.c1 - o1 * t.s1; } else { v0 = o0 * t.s0 + v0 * t.c0; v1 = o1 * t.s1 + v1 * t.c1; }
}
struct EpiMlaQ {
    static constexpr bool PERM = true, AFTER_DRAIN = false, RESID_LDS = false, PRE_RSTD = false;
    bf16_t* QM; const float* ssq2; const float* rope;
    __device__ __forceinline__ void operator()(const f32x4 (&acc)[2][2][4][2], const Unit& u, int wr, int wc, int fr, int fq) const {
        const int col0 = u.pn * BM + wc * 32 + 8 * fq, rowb = u.pm * BM + wr * 64 + fr;
        float rsv[2][4]; rows_rstd(rsv, ssq2, rowb, 0, 8, 1.f / 384.f, fq);
        const bool rg0 = (u.pn * 8 + wc) % 3 == 2, rg1 = (u.pn * 8 + 4 + wc) % 3 == 2;
#pragma unroll
        for (int am = 0; am < 4; ++am) { const int ai = am >> 1; RopeTab tb[2];
            if (rg0 || rg1) {
#pragma unroll
                for (int m2 = 0; m2 < 2; ++m2) tb[m2] = rope_load(rope, rowb + ai * HALF + ((am & 1) * 2 + m2) * 16, fq); }
#pragma unroll
            for (int m2 = 0; m2 < 2; ++m2) { const int m = (am & 1) * 2 + m2; int row = rowb + ai * HALF + m * 16; asm volatile("" : "+v"(row)); const float rs = rsv[ai][m];
#pragma unroll
                for (int bj = 0; bj < 2; ++bj) { f32x4 v0 = acc[ai][bj][m][0] * rs, v1 = acc[ai][bj][m][1] * rs;
                    if (bj == 0 ? rg0 : rg1) rope8(v0, v1, tb[m2], fq);
                    *(u32x4*)(QM + (size_t)row * 768 + col0 + bj * HALF) = pack8(v0, v1); } } }
    }
};
struct EpiMlaKV {
    static constexpr bool PERM = true, AFTER_DRAIN = false, RESID_LDS = false, PRE_RSTD = false;
    bf16_t* KM; bf16_t* VM; const bf16_t* Z1; const float* ssq2; const float* rope;
    __device__ __forceinline__ void operator()(const f32x4 (&acc)[2][2][4][2], const Unit& u, int wr, int wc, int fr, int fq) const {
        const int rowb = u.pm * BM + wr * 64 + fr;
        float rsv[2][4]; rows_rstd(rsv, ssq2, rowb, 8, 4, 1.f / 256.f, fq);
#pragma unroll
        for (int am = 0; am < 4; ++am) { const int ai = am >> 1; RopeTab tb[2]; u32x4 raw[2];
            if (wc == 0) {
#pragma unroll
                for (int m2 = 0; m2 < 2; ++m2) { const int r_ = rowb + ai * HALF + ((am & 1) * 2 + m2) * 16; tb[m2] = rope_load(rope, r_, fq); raw[m2] = *(const u32x4*)(Z1 + (size_t)r_ * 2816 + 2432 + 8 * fq); } }
#pragma unroll
            for (int m2 = 0; m2 < 2; ++m2) { const int m = (am & 1) * 2 + m2; int row = rowb + ai * HALF + m * 16; asm volatile("" : "+v"(row)); const float rs = rsv[ai][m];
#pragma unroll
                for (int bj = 0; bj < 2; ++bj) { const int h = 2 * u.pn + bj; const u32x4 w = pack8(acc[ai][bj][m][0] * rs, acc[ai][bj][m][1] * rs);
                    if (wc < 2) *(u32x4*)(KM + (size_t)row * 768 + h * 96 + wc * 32 + 8 * fq) = w; else *(u32x4*)(VM + (size_t)row * 512 + h * 64 + (wc - 2) * 32 + 8 * fq) = w; }
                if (wc == 0) { f32x4 v0, v1; const u32x4 r_ = raw[m2];
                    v0[0] = __uint_as_float(r_.x << 16); v0[1] = __uint_as_float(r_.x & 0xffff0000u); v0[2] = __uint_as_float(r_.y << 16); v0[3] = __uint_as_float(r_.y & 0xffff0000u);
                    v1[0] = __uint_as_float(r_.z << 16); v1[1] = __uint_as_float(r_.z & 0xffff0000u); v1[2] = __uint_as_float(r_.w << 16); v1[3] = __uint_as_float(r_.w & 0xffff0000u);
                    rope8(v0, v1, tb[m2], fq); const u32x4 w = pack8(v0, v1);
#pragma unroll
                    for (int bj = 0; bj < 2; ++bj) *(u32x4*)(KM + (size_t)row * 768 + (2 * u.pn + bj) * 96 + 64 + 8 * fq) = w; } } }
    }
};

template <class Epi, class Sched, bool ALIGN_EPI = false, bool SP2 = false, bool HALFA = false, bool CHAIN_IN = false>
__device__ __forceinline__ void gemm_phase(PG8_LAS unsigned char* lds, const Gemm g, const Sched& S, const Epi& E, const bool chain = false, const Unit chain_unit = Unit{0, 0, 0}) {
    int tid_ = threadIdx.x; asm volatile("" : "+v"(tid_));
    const int tid = tid_, wid = __builtin_amdgcn_readfirstlane(tid >> 6), lane = tid & 63, wr = wid >> 2, wc = wid & 3, fr = lane & 15, fq = lane >> 4;
    int K_ = g.K; asm volatile("" : "+s"(K_));
    const int K = K_, nt = K / BK;
    unsigned voffA[2], voffB[2];
#pragma unroll
    for (int i = 0; i < 2; ++i) { int R, C; stage_rc(tid * 16 + i * 8192, R, C); const int Rb = Epi::PERM ? ((R & ~31) + perm32(R & 31)) : R;
        voffA[i] = (unsigned)(R * g.lda + C) * 2u; voffB[i] = (unsigned)(Rb * K + C) * 2u; }
    const size_t kstep = (size_t)(BK * 2);
    const size_t hstep = (size_t)HALF * K * 2;
    const size_t tstep = 2 * hstep;
    const size_t hrowsA = (size_t)HALF * g.lda * 2, hstepA = HALFA ? 0 : hrowsA, tstepA = 2 * hrowsA;
    const unsigned ldsw = (unsigned)wid * 1024u;
    const int aoff = lds_byte(wr * 64 + fr, fq * 8), boff = lds_byte(wc * 32 + fr, fq * 8);
#define PG8_SA(b, h) (((b) * 2 + (h)) * HTB)
#define PG8_SB(b, h) ((4 + (b) * 2 + (h)) * HTB)
#define PG8_STAGE(bufoff, gbase, voff) do { _Pragma("unroll") for (int _i = 0; _i < 2; ++_i) \
        __builtin_amdgcn_global_load_lds((const unsigned*)((const char*)(gbase) + (voff)[_i]), (PG8_LAS unsigned*)(lds + (bufoff) + ldsw + _i * 8192), 16, 0, 0); } while (0)
#define PG8_STAGE_RS(bufoff, gbase, voff, p0) do { \
        const char* g0_ = (const char*)(gbase); const char* g1_ = g0_; unsigned v0_ = (voff)[0], v1_ = (voff)[1]; \
        if constexpr (Epi::RESID_LDS) { if (rs) { int z_ = 0; asm volatile("" : "+v"(z_)); const unsigned vr_ = Epi::lane_off(wr, wc, fr, fq) + (unsigned)z_;     \
            g0_ = rbase + Epi::piece_off(p0); g1_ = rbase + Epi::piece_off((p0) + 1); v0_ = vr_; v1_ = vr_; } } \
        __builtin_amdgcn_global_load_lds((const unsigned*)(g0_ + v0_), (PG8_LAS unsigned*)(lds + (bufoff) + ldsw), 16, 0, 0); \
        __builtin_amdgcn_global_load_lds((const unsigned*)(g1_ + v1_), (PG8_LAS unsigned*)(lds + (bufoff) + ldsw + 8192), 16, 0, 0); } while (0)
#define PG8_LDA(dst, b, h) do { _Pragma("unroll") for (int m = 0; m < 4; ++m) _Pragma("unroll") for (int k = 0; k < 2; ++k) dst[m][k] = *(const PG8_LAS bf16x8*)(lds + PG8_SA(b, h) + aoff + m * 2048 + k * 1024); } while (0)
#define PG8_LDB(dst, b, h) do { _Pragma("unroll") for (int n = 0; n < 2; ++n) _Pragma("unroll") for (int k = 0; k < 2; ++k) dst[n][k] = *(const PG8_LAS bf16x8*)(lds + PG8_SB(b, h) + boff + n * 2048 + k * 1024); } while (0)
#define PG8_MMA(ai, bj, At, Bt) do { __builtin_amdgcn_s_setprio(1); _Pragma("unroll") for (int m = 0; m < 4; ++m) _Pragma("unroll") for (int n = 0; n < 2; ++n) _Pragma("unroll") for (int k = 0; k < 2; ++k) \
        acc[ai][bj][m][n] = __builtin_amdgcn_mfma_f32_16x16x32_bf16(Bt[n][k], At[m][k], acc[ai][bj][m][n], 0, 0, 0); __builtin_amdgcn_s_setprio(0); } while (0)
#define PG8_WAIT_V(n) asm volatile("s_waitcnt vmcnt(" #n ")" ::: "memory")
#define PG8_WAIT_L(n) asm volatile("s_waitcnt lgkmcnt(" #n ")" ::: "memory")
#define PG8_BAR __builtin_amdgcn_s_barrier()
#define PG8_SCHED __builtin_amdgcn_sched_barrier(0)
    Unit cur, nxt; int ui = 0;
    if (!S.next(0, cur)) return;
    bool pre = false; if constexpr (Epi::PRE_RSTD) pre = E.pre_ok();
    PG8_LAS float* const rsbuf = (PG8_LAS float*)(lds + 8 * HTB); int rb = CHAIN_IN ? 2 : 0;
#define PG8_RS_ISSUE(q0, q1, un) do { if constexpr (Epi::PRE_RSTD) { const float* p_ = E.ssq + (size_t)((un).pm * BM + (tid >> 1)) * 16 + 8 * (tid & 1); q0 = *(const f32x4*)p_; q1 = *(const f32x4*)(p_ + 4); } } while (0)
#define PG8_RS_FINISH(q0, q1, bi) do { float s_ = ((q0[0] + q0[1]) + (q0[2] + q0[3])) + ((q1[0] + q1[1]) + (q1[2] + q1[3])); s_ += __shfl_xor(s_, 1); \
        if ((tid & 1) == 0) rsbuf[(bi) * 256 + (tid >> 1)] = rsqrtf(s_ * (1.f / 1024.f) + 1e-6f); } while (0)
    f32x4 pq0, pq1;
    if constexpr (!CHAIN_IN) { if (pre) PG8_RS_ISSUE(pq0, pq1, cur); }
    f32x4 acc[2][2][4][2];
#pragma unroll
    for (int a = 0; a < 2; ++a)
#pragma unroll
        for (int b = 0; b < 2; ++b)
#pragma unroll
            for (int m = 0; m < 4; ++m)
#pragma unroll
                for (int n = 0; n < 2; ++n) acc[a][b][m][n] = (f32x4){0.f, 0.f, 0.f, 0.f};
    bf16x8 At[4][2], B0[2][2], B1[2][2];
    const char* cA = (const char*)g.A + (size_t)cur.pm * tstepA + (HALFA ? (size_t)cur.h * hrowsA : 0); const char* cB = (const char*)g.Bt + (size_t)cur.pn * tstep;
    S.a_ready(cur);
    if constexpr (!CHAIN_IN) {
    if constexpr (SP2) {
        PG8_STAGE(PG8_SB(0, 0), cB, voffB); PG8_STAGE(PG8_SB(0, 1), cB + hstep, voffB); PG8_STAGE(PG8_SA(0, 0), cA, voffA); PG8_STAGE(PG8_SA(0, 1), cA + hstepA, voffA);
        if (wr == 1) PG8_BAR;
        PG8_WAIT_V(2); PG8_BAR;
        PG8_STAGE(PG8_SB(1, 0), cB + kstep, voffB); PG8_STAGE(PG8_SA(1, 0), cA + kstep, voffA); PG8_STAGE(PG8_SB(1, 1), cB + hstep + kstep, voffB);
        PG8_WAIT_V(6); PG8_BAR;
    } else {
        PG8_STAGE(PG8_SB(0, 0), cB, voffB); PG8_STAGE(PG8_SA(0, 0), cA, voffA); PG8_STAGE(PG8_SB(0, 1), cB + hstep, voffB); PG8_STAGE(PG8_SA(0, 1), cA + hstepA, voffA);
        if (wr == 1) PG8_BAR;
        PG8_WAIT_V(4); PG8_BAR;
        PG8_STAGE(PG8_SB(1, 0), cB + kstep, voffB); PG8_STAGE(PG8_SA(1, 0), cA + kstep, voffA); PG8_STAGE(PG8_SB(1, 1), cB + hstep + kstep, voffB);
        PG8_WAIT_V(6); PG8_BAR;
    }
    if (pre) PG8_RS_FINISH(pq0, pq1, 0);
    }
    for (;;) {
        const bool has_next = S.next(ui + 1, nxt);
        const bool chained = !has_next && chain; if (chained) nxt = chain_unit;
        const bool pf = has_next || chained;
        const char* nA = pf ? (const char*)g.A + (size_t)nxt.pm * tstepA + ((HALFA || chained) ? (size_t)nxt.h * hrowsA : 0) : cA; const char* nB = pf ? (const char*)g.Bt + (size_t)nxt.pn * tstep : cB;
        for (int t = 0; t < nt; t += 2) {
            const bool last = (t == nt - 2);
            const char* a1 = cA + (size_t)(t + 1) * kstep;
            const char* a2 = last ? nA : cA + (size_t)(t + 2) * kstep; const char* b2 = last ? nB : cB + (size_t)(t + 2) * kstep;
            const char* a3 = a2 + kstep; const char* b3 = b2 + kstep;
            if (last && has_next) S.a_ready(nxt);
            const bool rs = Epi::RESID_LDS && last && !has_next; const char* rbase = nullptr;
            if constexpr (Epi::RESID_LDS) rbase = E.tile_base(cur);
            if constexpr (SP2) {
            PG8_LDB(B0, 0, 0); PG8_LDB(B1, 0, 1); PG8_SCHED; PG8_LDA(At, 0, 0); PG8_STAGE(PG8_SA(1, 1), a1 + hstepA, voffA);
            PG8_WAIT_V(8); PG8_WAIT_L(0); PG8_BAR; PG8_MMA(0, 0, At, B0); PG8_MMA(0, 1, At, B1); PG8_BAR; PG8_SCHED;
            if constexpr (!HALFA) PG8_LDA(At, 0, 1); PG8_STAGE_RS(PG8_SB(0, 0), b2, voffB, 0); PG8_STAGE_RS(PG8_SB(0, 1), b2 + hstep, voffB, 2); PG8_STAGE_RS(PG8_SA(0, 0), a2, voffA, 4);
            PG8_WAIT_V(8); PG8_WAIT_L(0); PG8_BAR; if constexpr (!HALFA) { PG8_MMA(1, 0, At, B0); PG8_MMA(1, 1, At, B1); } PG8_BAR; PG8_SCHED;
            PG8_LDB(B0, 1, 0); PG8_LDB(B1, 1, 1); PG8_SCHED; PG8_LDA(At, 1, 0); PG8_STAGE_RS(PG8_SA(0, 1), a2 + hstepA, voffA, 6);
            PG8_WAIT_V(8); PG8_WAIT_L(0); PG8_BAR; PG8_MMA(0, 0, At, B0); PG8_MMA(0, 1, At, B1); PG8_BAR; PG8_SCHED;
            if constexpr (!HALFA) PG8_LDA(At, 1, 1); PG8_STAGE_RS(PG8_SB(1, 0), b3, voffB, 8); PG8_STAGE_RS(PG8_SB(1, 1), b3 + hstep, voffB, 10); PG8_STAGE_RS(PG8_SA(1, 0), a3, voffA, 12);
            PG8_WAIT_V(8); PG8_WAIT_L(0); PG8_BAR; if constexpr (!HALFA) { PG8_MMA(1, 0, At, B0); PG8_MMA(1, 1, At, B1); } PG8_BAR; PG8_SCHED;
            } else {
            PG8_LDB(B0, 0, 0); PG8_SCHED; PG8_LDA(At, 0, 0); PG8_STAGE(PG8_SA(1, 1), a1 + hstepA, voffA);
            PG8_WAIT_L(8); PG8_BAR; PG8_WAIT_L(0); PG8_MMA(0, 0, At, B0); PG8_BAR; PG8_SCHED;
            PG8_LDB(B1, 0, 1); PG8_STAGE(PG8_SB(0, 0), b2, voffB);
            PG8_BAR; PG8_WAIT_L(0); PG8_MMA(0, 1, At, B1); PG8_BAR;
            PG8_LDA(At, 0, 1); PG8_STAGE(PG8_SA(0, 0), a2, voffA);
            PG8_BAR; PG8_WAIT_L(0); PG8_MMA(1, 0, At, B0); PG8_BAR; PG8_SCHED;
            PG8_STAGE(PG8_SB(0, 1), b2 + hstep, voffB);
            PG8_WAIT_V(6); PG8_BAR; PG8_MMA(1, 1, At, B1); PG8_BAR;
            PG8_LDB(B0, 1, 0); PG8_SCHED; PG8_LDA(At, 1, 0); PG8_STAGE(PG8_SA(0, 1), a2 + hstepA, voffA);
            PG8_WAIT_L(8); PG8_BAR; PG8_WAIT_L(0); PG8_MMA(0, 0, At, B0); PG8_BAR; PG8_SCHED;
            PG8_LDB(B1, 1, 1); PG8_STAGE(PG8_SB(1, 0), b3, voffB);
            PG8_BAR; PG8_WAIT_L(0); PG8_MMA(0, 1, At, B1); PG8_BAR;
            PG8_LDA(At, 1, 1); PG8_STAGE(PG8_SA(1, 0), a3, voffA);
            PG8_BAR; PG8_WAIT_L(0); PG8_MMA(1, 0, At, B0); PG8_BAR; PG8_SCHED;
            PG8_STAGE(PG8_SB(1, 1), b3 + hstep, voffB);
            PG8_WAIT_V(6); PG8_BAR; PG8_MMA(1, 1, At, B1); PG8_BAR;
            }
        }
        if constexpr (ALIGN_EPI) { if (wr == 0) PG8_BAR; }
        if constexpr (Epi::PRE_RSTD) {
            const int nb = chained ? 2 : (rb == 0 ? 1 : 0);
            f32x4 eq0, eq1;
            if (pre && pf) PG8_RS_ISSUE(eq0, eq1, nxt);
            const PG8_LAS float* rsp = pre ? rsbuf + rb * 256 : nullptr;
            if constexpr (HALFA) E.half(acc, cur, wr, wc, fr, fq, rsp); else E(acc, cur, wr, wc, fr, fq, rsp);
            if (pre && pf) PG8_RS_FINISH(eq0, eq1, nb);
            rb = nb; S.done(cur); }
        else if constexpr (HALFA) { E.half(acc, cur, wr, wc, fr, fq); S.done(cur); }
        else if constexpr (Epi::RESID_LDS && SP2) { if (!has_next) E.lds_epi(acc, cur, wr, wc, fr, fq, lds, wid, lane); else E(acc, cur, wr, wc, fr, fq); S.done(cur); }
        else if constexpr (!Epi::AFTER_DRAIN) { E(acc, cur, wr, wc, fr, fq); S.done(cur); }
        if (!has_next) { if (chained) { if constexpr (ALIGN_EPI) { if (wr == 1) PG8_BAR; } return; } break; }
#pragma unroll
        for (int a = 0; a < 2; ++a)
#pragma unroll
            for (int b = 0; b < 2; ++b)
#pragma unroll
                for (int m = 0; m < 4; ++m)
#pragma unroll
                    for (int n = 0; n < 2; ++n) acc[a][b][m][n] = (f32x4){0.f, 0.f, 0.f, 0.f};
        cur = nxt; cA = nA; cB = nB; ++ui;
        if constexpr (ALIGN_EPI) { if (wr == 1) PG8_BAR; }
    }
    PG8_WAIT_V(0);
    if constexpr (!ALIGN_EPI) { if (wr == 0) PG8_BAR; }
    PG8_BAR;
    if constexpr (Epi::AFTER_DRAIN) { E.fused(acc, cur, wr, wc, fr, fq, lds, wid, lane); S.done(cur); }
#undef PG8_SA
#undef PG8_SB
#undef PG8_STAGE
#undef PG8_STAGE_RS
#undef PG8_RS_ISSUE
#undef PG8_RS_FINISH
#undef PG8_LDA
#undef PG8_LDB
#undef PG8_MMA
#undef PG8_WAIT_V
#undef PG8_WAIT_L
#undef PG8_BAR
#undef PG8_SCHED
}
}
#define GAS __attribute__((address_space(1)))
#define LAS __attribute__((address_space(3)))
typedef unsigned short bf16;
typedef unsigned v4u __attribute__((ext_vector_type(4)));
typedef float f32x4 __attribute__((ext_vector_type(4)));
typedef short bf16x8 __attribute__((ext_vector_type(8)));
typedef GAS unsigned gu32;
typedef GAS unsigned long long gu64;
#define RLX_AGENT __ATOMIC_RELAXED, __HIP_MEMORY_SCOPE_AGENT
#define LDS_WAIT() asm volatile("s_waitcnt lgkmcnt(0)" ::: "memory")
#define VM_WAIT() asm volatile("s_waitcnt vmcnt(0)" ::: "memory")
__device__ __forceinline__ unsigned long long rt() { return __builtin_amdgcn_s_memrealtime(); }
__device__ __forceinline__ unsigned f2bf(float f) { unsigned u = __builtin_bit_cast(unsigned, f); return (u + 0x7fffu + ((u >> 16) & 1u)) >> 16; }
__device__ __forceinline__ unsigned pk2(float lo, float hi) { return f2bf(lo) | (f2bf(hi) << 16); }

#define XB_TMO      128
#define XB_XCNT(j)  (256  + 64 * (j))
#define XB_XSUB(j)  (1280 + 64 * (j))
#define XB_XGEN(j)  (2304 + 64 * (j))
#define XB_TOP      3328
#define XB_TOPGEN   3392
#define XCD_BAR_WORDS 3456
#define XB_SPIN_CAP (1u << 18)

__device__ __forceinline__ unsigned xb_ld(unsigned* p)              { return __hip_atomic_load(p, __ATOMIC_RELAXED, __HIP_MEMORY_SCOPE_AGENT); }
__device__ __forceinline__ unsigned xb_add(unsigned* p, unsigned v) { return __hip_atomic_fetch_add(p, v, __ATOMIC_RELAXED, __HIP_MEMORY_SCOPE_AGENT); }
__device__ __forceinline__ unsigned xb_xcc_id() { return (unsigned)__builtin_amdgcn_s_getreg((3 << 11) | 20) & 0xFu; }
#define XB_SPIN(cond, bar) do { unsigned _sp = 0; while (cond) { __builtin_amdgcn_s_sleep(1); \
    if ((++_sp & 255u) == 0u) { if (xb_ld(&(bar)[XB_TMO])) break; if (_sp > XB_SPIN_CAP) { atomicAdd(&(bar)[XB_TMO], 1u); break; } } } } while (0)

struct XcdBarrier {
    unsigned* bar; unsigned x;
    volatile LAS unsigned* st;
};

__device__ __forceinline__ XcdBarrier xcd_barrier_post(unsigned* bar, volatile LAS unsigned* st) {
    XcdBarrier b; b.bar = bar; b.x = xb_xcc_id(); b.st = st;
    if (threadIdx.x == 0) (void)xb_add(&bar[XB_XCNT(b.x)], 1u);
    return b;
}
__device__ __forceinline__ void xcd_barrier_complete(unsigned* bar, unsigned x, unsigned& nloc, unsigned& nx) {
    const unsigned G = gridDim.x * gridDim.y * gridDim.z;
    unsigned sum, cnt, mine, sp = 0u;
    for (;;) {
        sum = 0u; cnt = 0u; mine = 0u;
#pragma unroll
        for (unsigned j = 0; j < 16; ++j) { const unsigned c = xb_ld(&bar[XB_XCNT(j)]); sum += c; cnt += (c > 0u) ? 1u : 0u; mine = (j == x) ? c : mine; }
        if (sum == G) break;
        __builtin_amdgcn_s_sleep(1);
        if ((++sp & 255u) == 0u) { if (xb_ld(&bar[XB_TMO])) break; if (sp > XB_SPIN_CAP) { atomicAdd(&bar[XB_TMO], 1u); break; } }
    }
    nloc = mine > 0u ? mine : 1u; nx = cnt > 0u ? cnt : 1u;
}

__device__ __forceinline__ void xcd_barrier(const XcdBarrier& b) {
    asm volatile("s_waitcnt vmcnt(0)" ::: "memory");
    __syncthreads();
    if (threadIdx.x == 0) {
        unsigned* bar = b.bar;
        __builtin_amdgcn_s_waitcnt(0);
        unsigned nloc = b.st[0], nx = b.st[1];
        if (nloc == 0u) { xcd_barrier_complete(bar, b.x, nloc, nx); b.st[0] = nloc; b.st[1] = nx; }
        const unsigned old = xb_add(&bar[XB_XSUB(b.x)], 1u);
        const unsigned gen = old / nloc;
        if (old + 1u == (gen + 1u) * nloc) {
            __builtin_amdgcn_fence(__ATOMIC_RELEASE, "agent");
            asm volatile("s_waitcnt vmcnt(0)" ::: "memory");
            const unsigned og = xb_add(&bar[XB_TOP], 1u);
            const unsigned tg = og / nx;
            if (og + 1u == (tg + 1u) * nx) xb_add(&bar[XB_TOPGEN], 1u);
            else XB_SPIN(xb_ld(&bar[XB_TOPGEN]) == tg, bar);
            __builtin_amdgcn_fence(__ATOMIC_ACQUIRE, "agent");
            xb_add(&bar[XB_XGEN(b.x)], 1u);
            asm volatile("s_waitcnt vmcnt(0)" ::: "memory");
        } else {
            XB_SPIN(xb_ld(&bar[XB_XGEN(b.x)]) == gen, bar);
            __builtin_amdgcn_fence(__ATOMIC_ACQUIRE, "agent");
            asm volatile("s_waitcnt vmcnt(0)" ::: "memory");
        }
    }
    __syncthreads();
}
constexpr int NWAVES = 8;
constexpr int RING_OFF = 0, RING_BYTES = 139264;
constexpr int LDSCTL_OFF = RING_BYTES, MISC_OFF = LDSCTL_OFF + 320;
constexpr int LDS_BYTES = 147456;
constexpr int CW_FIN = 4096 + 2 * 3456;
constexpr int CW_BAR = 4096;
constexpr size_t WS_SSQ2 = 2 * MiB;
constexpr size_t WS_ROPE = 254 * MiB;
constexpr size_t WB_EVIN = 0, WB_EVOUT = WB_EVIN + 2048 * 1024, WB_POOL = WB_EVOUT + 1024 * 1024, WB_Q0 = WB_POOL + 4 * 128 * 128, WB_O0 = WB_Q0 + 512 * 1024,
                 WB_GU0 = WB_O0 + 1024 * 512, WB_DN0 = WB_GU0 + 5632 * 1024, WB_ODIN = WB_DN0 + 1024 * 2816, WB_UQ = WB_ODIN + 2816 * 1024, WB_UKV = WB_UQ + 768 * 384,
                 WB_ODOUT = WB_UKV + 1024 * 256, WB_Q1 = WB_ODOUT + 1024 * 1024, WB_O1 = WB_Q1 + 512 * 1024, WB_GU1 = WB_O1 + 1024 * 512, WB_DN1 = WB_GU1 + 5632 * 1024,
                 WB_KV = WB_DN1 + 1024 * 2816, WB_ENDE = WB_KV + 2048 * 1024;
static_assert(WB_ENDE * 2 <= 60 * MiB, "bf16 weights fit their region");
constexpr int NMATS = 20;
struct Mat { const float* W; const float* gain; bf16_t* dst; int ldw, K, Ndst, map; };
struct Args { const float* in[26]; float* out; unsigned char* ws; Mat mats[NMATS]; int ph_lo, ph_hi, li, pad; };

struct Frame {
    LAS unsigned char* lds; volatile LAS unsigned* MISC; gu32* ctl;
    int tid, lane, wave, vcu, G;
};
__device__ __forceinline__ float wave_sum(float v) {
#pragma unroll
    for (int o = 1; o < 64; o <<= 1) v += __shfl_xor(v, o);
    return v;
}
__device__ __forceinline__ int src_col(int map, int r0, int& valid) {
    valid = 32;
    if (map == 0) return r0;
    if (map == 1) { const int tile = r0 >> 8, w = r0 & 255; return (w < 128) ? 128 * tile + w : 2816 + 128 * tile + (w - 128); }
    if (r0 < 2048) return r0;
    if (r0 < 2432) return 2056 + (r0 - 2048);
    if (r0 == 2432) return 2696;
    if (r0 == 2464) { valid = 8; return 2048; }
    if (r0 < 2560) { valid = 0; return 0; }
    return 2440 + (r0 - 2560);
}
__device__ __forceinline__ void p0_transpose_item(const Mat& mt, LAS float* scr, int item, int lane) {
    const int nblk = mt.Ndst / 64, kb = item / nblk, nb = item % nblk, k0 = 64 * kb, n0 = 64 * nb;
    const int cq = lane & 15, kr = lane >> 4, hf = cq >> 3;
    int valid; const int sc = src_col(mt.map, n0 + 32 * hf, valid);
    const bool ok = 4 * (cq & 7) < valid;
    const float* src = mt.W + (size_t)(k0 + kr) * mt.ldw + (ok ? sc + 4 * (cq & 7) : 0);
    f32x4 v[16]; float gn[16]; const float okf = ok ? 1.f : 0.f;
    if (mt.gain) {
#pragma unroll
        for (int i = 0; i < 16; ++i) gn[i] = mt.gain[k0 + kr + 4 * i];
    } else {
#pragma unroll
        for (int i = 0; i < 16; ++i) gn[i] = 1.f; }
#pragma unroll
    for (int i = 0; i < 16; ++i) v[i] = __builtin_nontemporal_load((const GAS f32x4*)(src + (size_t)(4 * i) * mt.ldw));
#pragma unroll
    for (int i = 0; i < 16; ++i) v[i] = v[i] * (gn[i] * okf);
#pragma unroll
    for (int i = 0; i < 16; ++i) { LAS float* d = scr + (kr + 4 * i) * 65 + 4 * cq; d[0] = v[i].x; d[1] = v[i].y; d[2] = v[i].z; d[3] = v[i].w; }
    LDS_WAIT(); asm volatile("" ::: "memory");
    const int c = lane & 7;
#pragma unroll
    for (int j = 0; j < 8; ++j) { const int n = (lane >> 3) + 8 * j; const LAS float* s_ = scr + (8 * c) * 65 + n;
        v4u o; o.x = pk2(s_[0 * 65], s_[1 * 65]); o.y = pk2(s_[2 * 65], s_[3 * 65]); o.z = pk2(s_[4 * 65], s_[5 * 65]); o.w = pk2(s_[6 * 65], s_[7 * 65]);
        *(GAS v4u*)(mt.dst + (size_t)(n0 + n) * mt.K + k0 + 8 * c) = o; }
    LDS_WAIT(); asm volatile("" ::: "memory");
}
__device__ __forceinline__ float row_to_bf16(const float* xrow, bf16_t* orow, bool normalize, int lane) {
    const GAS f32x4* xr = (const GAS f32x4*)xrow + lane;
    f32x4 v[4]; float s = 0.f;
#pragma unroll
    for (int j = 0; j < 4; ++j) { v[j] = xr[64 * j]; s += (v[j].x * v[j].x + v[j].y * v[j].y) + (v[j].z * v[j].z + v[j].w * v[j].w); }
    s = wave_sum(s);
    const float sc = normalize ? rsqrtf(s * (1.f / 1024.f) + 1e-6f) : 1.f;
    GAS unsigned long long* o8 = (GAS unsigned long long*)orow + lane;
#pragma unroll
    for (int j = 0; j < 4; ++j) o8[64 * j] = (unsigned long long)pk2(v[j].x * sc, v[j].y * sc) | ((unsigned long long)pk2(v[j].z * sc, v[j].w * sc) << 32);
    return s;
}
constexpr int NMATS_MID = 18;
constexpr int NMATS_EARLY = 9;
__device__ __forceinline__ void p0_convert(const Args& args, LAS float* scr, int m_lo, int m_hi, int gw, int NGW, int lane) {
    int base = 0;
    for (int mi = m_lo; mi < m_hi; ++mi) {
        const Mat mt = args.mats[mi]; const int nit = (mt.K / 64) * (mt.Ndst / 64);
        int first = (gw - (base % NGW) + NGW) % NGW;
        for (int it = first; it < nit; it += NGW) p0_transpose_item(mt, scr, it, lane);
        base += nit;
    }
}
__device__ __forceinline__ void p0_prologue(Frame& F, const Args& args) {
    int tid_ = threadIdx.x; asm volatile("" : "+v"(tid_)); const int lane_ = tid_ & 63, wave_ = __builtin_amdgcn_readfirstlane(tid_ >> 6);
    LAS float* scr = (LAS float*)(F.lds + RING_OFF + wave_ * 16640);
    const int gw = F.vcu * NWAVES + wave_, NGW = F.G * NWAVES;
    unsigned char* ws = args.ws;
    bf16_t* XB = (bf16_t*)(ws + WS_XB); float* SSQ = (float*)(ws + WS_SSQ); bf16_t* MEMN = (bf16_t*)(ws + WS_MEMN); float* ROPE = (float*)(ws + WS_ROPE);
    const float* x = args.in[0]; const float* mem = args.in[1]; const int* pos = (const int*)args.in[2];
    for (int m = gw; m < MTOK; m += 2 * NGW) {
        const int m2 = m + NGW; const GAS f32x4* xa = (const GAS f32x4*)(x + (size_t)m * DM) + lane_; const GAS f32x4* xb2 = (const GAS f32x4*)(x + (size_t)(m2 < MTOK ? m2 : m) * DM) + lane_;
        f32x4 va[4], vb[4]; float sa = 0.f, sb = 0.f;
#pragma unroll
        for (int j = 0; j < 4; ++j) { va[j] = __builtin_nontemporal_load(&xa[64 * j]); vb[j] = __builtin_nontemporal_load(&xb2[64 * j]); }
#pragma unroll
        for (int j = 0; j < 4; ++j) { sa += (va[j].x * va[j].x + va[j].y * va[j].y) + (va[j].z * va[j].z + va[j].w * va[j].w); sb += (vb[j].x * vb[j].x + vb[j].y * vb[j].y) + (vb[j].z * vb[j].z + vb[j].w * vb[j].w); }
        sa = wave_sum(sa); sb = wave_sum(sb);
        GAS unsigned long long* oa = (GAS unsigned long long*)(XB + (size_t)m * DM) + lane_;
#pragma unroll
        for (int j = 0; j < 4; ++j) oa[64 * j] = (unsigned long long)pk2(va[j].x, va[j].y) | ((unsigned long long)pk2(va[j].z, va[j].w) << 32);
        if (lane_ < 16) SSQ[(size_t)m * 16 + lane_] = (lane_ == 0) ? sa : 0.f;
        if (m2 < MTOK) { GAS unsigned long long* ob = (GAS unsigned long long*)(XB + (size_t)m2 * DM) + lane_;
#pragma unroll
            for (int j = 0; j < 4; ++j) ob[64 * j] = (unsigned long long)pk2(vb[j].x, vb[j].y) | ((unsigned long long)pk2(vb[j].z, vb[j].w) << 32);
            if (lane_ < 16) SSQ[(size_t)m2 * 16 + lane_] = (lane_ == 0) ? sb : 0.f; }
    }
    p0_convert(args, scr, 0, NMATS_EARLY, gw, NGW, lane_);
    for (int m = gw; m < BATCH * NMEM; m += NGW) (void)row_to_bf16(mem + (size_t)m * DM, MEMN + (size_t)m * DM, true, lane_);
    for (int i = gw * 64 + lane_; i < MTOK * 16; i += NGW * 64) { const int row = i >> 4, k = i & 15;
        const float ang = (float)pos[row] * powf(10000.0f, -(float)k / 16.0f); ROPE[(size_t)row * 32 + k] = cosf(ang); ROPE[(size_t)row * 32 + 16 + k] = sinf(ang); }
}
typedef float f32x16 __attribute__((ext_vector_type(16)));
typedef short s16x4 __attribute__((ext_vector_type(4)));
typedef unsigned v2u __attribute__((ext_vector_type(2)));
__device__ __forceinline__ float bflo(unsigned u) { return __uint_as_float(u << 16); }
__device__ __forceinline__ float bfhi(unsigned u) { return __uint_as_float(u & 0xffff0000u); }
__device__ __forceinline__ void unpack8(const v4u r, float (&f)[8]) { f[0] = bflo(r.x); f[1] = bfhi(r.x); f[2] = bflo(r.y); f[3] = bfhi(r.y); f[4] = bflo(r.z); f[5] = bfhi(r.z); f[6] = bflo(r.w); f[7] = bfhi(r.w); }
__device__ __forceinline__ unsigned pkbf2(float lo, float hi) { typedef float f2 __attribute__((ext_vector_type(2))); typedef __bf16 b2 __attribute__((ext_vector_type(2))); f2 v = {lo, hi}; b2 b = __builtin_convertvector(v, b2); return __builtin_bit_cast(unsigned, b); }
template <int WIN> __device__ __forceinline__ void evenmix_pool(const bf16_t* zb  , int tta, LAS unsigned char* dst  , int RS) {
    v4u xr[WIN + 7];
#pragma unroll
    for (int i = 0; i < WIN + 7; ++i) { const int d = i - (WIN - 1); const bool ok = tta + d >= 0; xr[i] = *(const GAS v4u*)(zb + (ok ? (long)d * 2048 : 0)); if (!ok) xr[i] = (v4u){0u, 0u, 0u, 0u}; }
    float sm[8];
#pragma unroll
    for (int e = 0; e < 8; ++e) sm[e] = 0.f;
#pragma unroll
    for (int i = 0; i < WIN - 1; ++i) { float xv[8]; unpack8(xr[i], xv);
#pragma unroll
        for (int e = 0; e < 8; ++e) sm[e] += xv[e]; }
#pragma unroll
    for (int j = 0; j < 8; ++j) { float x0[8]; unpack8(xr[j + WIN - 1], x0);
        const int tt = tta + j; const int cnt = (tt + 1 < WIN) ? tt + 1 : WIN; const float ic = 1.f / (float)cnt;
#pragma unroll
        for (int e = 0; e < 8; ++e) sm[e] += x0[e];
        v4u dq; dq.x = pkbf2(sm[0] * ic - x0[0], sm[1] * ic - x0[1]); dq.y = pkbf2(sm[2] * ic - x0[2], sm[3] * ic - x0[3]); dq.z = pkbf2(sm[4] * ic - x0[4], sm[5] * ic - x0[5]); dq.w = pkbf2(sm[6] * ic - x0[6], sm[7] * ic - x0[7]);
        *(LAS v4u*)(dst + j * RS) = dq;
        float xo[8]; unpack8(xr[j], xo);
#pragma unroll
        for (int e = 0; e < 8; ++e) sm[e] -= xo[e]; }
}
__device__ __forceinline__ void evenmix_phase(Frame& F, const Args& args) {
    constexpr int RS = 1040;
    unsigned char* ws = args.ws; const bf16_t* Z = (const bf16_t*)(ws + WS_Z); bf16_t* YMIX = (bf16_t*)(ws + WS_YMIX);
    const bf16_t* WP = (const bf16_t*)(ws + WS_WB) + WB_POOL; const float* conv_w = args.in[13]; const float* pscale = args.in[15];
    int tid = threadIdx.x; asm volatile("" : "+v"(tid));
    const int lane = tid & 63, wave = __builtin_amdgcn_readfirstlane(tid >> 6), fr = lane & 15, fq = lane >> 4;
    const int gi = wave >> 1, nh = wave & 1;
    const int c0 = gi * 128 + 8 * (lane & 15);
    for (int tile = F.vcu; tile < MTOK / 64; tile += F.G) {
        const int row0 = tile * 64, rl0 = nh * 32 + 8 * (lane >> 4), rowa = row0 + rl0, tta = rowa & (SEQ - 1);
        const bf16_t* zb = Z + (size_t)rowa * 2048 + c0;
        { v4u gb[8], gc[10], xa[10]; float cw[3][8];
#pragma unroll
          for (int j = 0; j < 8; ++j) gb[j] = __builtin_nontemporal_load((const GAS v4u*)(zb + (size_t)j * 2048));
#pragma unroll
          for (int j = 0; j < 10; ++j) { const bool ok = tta + j - 2 >= 0; const bf16_t* zp = zb + (ok ? ((long)j - 2) * 2048 : 0);
              gc[j] = __builtin_nontemporal_load((const GAS v4u*)(zp + 512)); xa[j] = __builtin_nontemporal_load((const GAS v4u*)(zp + 1024)); if (!ok) { gc[j] = (v4u){0u, 0u, 0u, 0u}; xa[j] = (v4u){0u, 0u, 0u, 0u}; } }
#pragma unroll
          for (int k = 0; k < 3; ++k)
#pragma unroll
              for (int e = 0; e < 8; ++e) cw[k][e] = conv_w[k * 512 + c0 + e];
#pragma unroll
          for (int j = 0; j < 8; ++j) { float acc[8], a_[8], b_[8];
#pragma unroll
              for (int e = 0; e < 8; ++e) acc[e] = 0.f;
#pragma unroll
              for (int k = 0; k < 3; ++k) { unpack8(gc[j + k], a_); unpack8(xa[j + k], b_);
#pragma unroll
                  for (int e = 0; e < 8; ++e) acc[e] += cw[k][e] * (a_[e] * b_[e]); }
              unpack8(gb[j], a_);
              v4u o; o.x = pkbf2(a_[0] * acc[0], a_[1] * acc[1]); o.y = pkbf2(a_[2] * acc[2], a_[3] * acc[3]); o.z = pkbf2(a_[4] * acc[4], a_[5] * acc[5]); o.w = pkbf2(a_[6] * acc[6], a_[7] * acc[7]);
              *(GAS v4u*)(YMIX + (size_t)(rowa + j) * 1024 + c0) = o; } }
        { LAS unsigned char* dst = F.lds + rl0 * RS + c0 * 2;
          if (gi == 0) evenmix_pool<2>(zb + 1536, tta, dst, RS); else if (gi == 1) evenmix_pool<4>(zb + 1536, tta, dst, RS); else if (gi == 2) evenmix_pool<8>(zb + 1536, tta, dst, RS); else evenmix_pool<16>(zb + 1536, tta, dst, RS); }
        pg8::bf16x8 Bf[4][4];
#pragma unroll
        for (int nt = 0; nt < 4; ++nt)
#pragma unroll
            for (int ks = 0; ks < 4; ++ks) Bf[nt][ks] = *(const pg8::bf16x8*)(WP + (size_t)gi * 128 * 128 + (size_t)(nh * 64 + nt * 16 + fr) * 128 + ks * 32 + 8 * fq);
        __syncthreads();
        pg8::f32x4 acc[4][4];
#pragma unroll
        for (int mt = 0; mt < 4; ++mt)
#pragma unroll
            for (int nt = 0; nt < 4; ++nt) acc[mt][nt] = (pg8::f32x4){0.f, 0.f, 0.f, 0.f};
#pragma unroll
        for (int ks = 0; ks < 4; ++ks) {
            pg8::bf16x8 Af[4];
#pragma unroll
            for (int mt = 0; mt < 4; ++mt) Af[mt] = *(const LAS pg8::bf16x8*)(F.lds + (mt * 16 + fr) * RS + (gi * 128 + ks * 32 + 8 * fq) * 2);
#pragma unroll
            for (int mt = 0; mt < 4; ++mt)
#pragma unroll
                for (int nt = 0; nt < 4; ++nt) acc[mt][nt] = __builtin_amdgcn_mfma_f32_16x16x32_bf16(Bf[nt][ks], Af[mt], acc[mt][nt], 0, 0, 0);
        }
#pragma unroll
        for (int nt = 0; nt < 4; ++nt) { const int col = gi * 128 + nh * 64 + nt * 16 + 4 * fq; const pg8::f32x4 sc = *(const pg8::f32x4*)(pscale + col);
#pragma unroll
            for (int mt = 0; mt < 4; ++mt) { const pg8::f32x4 v = acc[mt][nt] * sc; v2u w; w.x = pkbf2(v[0], v[1]); w.y = pkbf2(v[2], v[3]);
                *(GAS v2u*)(YMIX + (size_t)(row0 + mt * 16 + fr) * 1024 + 512 + col) = w; } }
        __syncthreads();
    }
}
typedef short v4i16_t __attribute__((ext_vector_type(4)));
__device__ __forceinline__ s16x4 vtr(const LAS unsigned char* p) { return __builtin_bit_cast(s16x4, __builtin_amdgcn_ds_read_tr16_b64_v4i16((LAS v4i16_t*)p)); }
__device__ __forceinline__ pg8::bf16x8 cat8(const s16x4 lo, const s16x4 hi) { return (pg8::bf16x8){lo[0], lo[1], lo[2], lo[3], hi[0], hi[1], hi[2], hi[3]}; }
__device__ __forceinline__ float xhalf_max(float m) { auto rr = __builtin_amdgcn_permlane32_swap(__float_as_uint(m), __float_as_uint(m), false, false); return fmaxf(__uint_as_float(rr[0]), __uint_as_float(rr[1])); }
__device__ __forceinline__ float xhalf_sum(float m) { auto rr = __builtin_amdgcn_permlane32_swap(__float_as_uint(m), __float_as_uint(m), false, false); return __uint_as_float(rr[0]) + __uint_as_float(rr[1]); }
__device__ __forceinline__ void xattn_phase(Frame& F, const Args& args, int l) {
    constexpr int RSK = 272, RSV = 320;
    unsigned char* ws = args.ws; const bf16_t* QX = (const bf16_t*)(ws + WS_Z); bf16_t* OX = (bf16_t*)(ws + WS_Z) + (size_t)MTOK * 512;
    const bf16_t* MKV = (const bf16_t*)(ws + WS_MEMKV) + (size_t)l * 1024 * 1024;
    int tid = threadIdx.x; asm volatile("" : "+v"(tid));
    const int lane = tid & 63, wave = __builtin_amdgcn_readfirstlane(tid >> 6), r32 = lane & 31, h5 = lane >> 5;
    const float C2 = 0.08838834764831845f * 1.4426950408889634f;
    for (int u = F.vcu; u < (MTOK / 256) * 4; u += F.G) {
        const int qt = u >> 2, h = u & 3, b = qt >> 4;
        const bf16_t* Kg = MKV + (size_t)(b * NMEM) * 1024 + h * 128; const bf16_t* Vg = Kg + 512;
        { v4u st[8];
#pragma unroll
          for (int i = 0; i < 8; ++i) { const int c = tid + 512 * i, key = c >> 4, ch = c & 15; st[i] = *(const GAS v4u*)(Kg + (size_t)key * 1024 + ch * 8); }
#pragma unroll
          for (int i = 0; i < 8; ++i) { const int c = tid + 512 * i, key = c >> 4, ch = c & 15; *(LAS v4u*)(F.lds + key * RSK + ch * 16) = st[i]; } }
        const int qrow = qt * 256 + wave * 32 + r32;
        pg8::bf16x8 qf[8];
#pragma unroll
        for (int kd = 0; kd < 8; ++kd) qf[kd] = *(const pg8::bf16x8*)(QX + (size_t)qrow * 512 + h * 128 + kd * 16 + 8 * h5);
        __syncthreads();
        f32x16 sa[8];
#pragma unroll
        for (int kb = 0; kb < 8; ++kb) { sa[kb] = (f32x16){};
#pragma unroll
            for (int kd = 0; kd < 8; ++kd) { const pg8::bf16x8 kf = *(const LAS pg8::bf16x8*)(F.lds + (kb * 32 + r32) * RSK + (kd * 16 + 8 * h5) * 2);
                sa[kb] = __builtin_amdgcn_mfma_f32_32x32x16_bf16(kf, qf[kd], sa[kb], 0, 0, 0); } }
        __syncthreads();
        { v4u st[8];
#pragma unroll
          for (int i = 0; i < 8; ++i) { const int c = tid + 512 * i, key = c >> 4, ch = c & 15; st[i] = *(const GAS v4u*)(Vg + (size_t)key * 1024 + ch * 8); }
#pragma unroll
          for (int i = 0; i < 8; ++i) { const int c = tid + 512 * i, key = c >> 4, ch = c & 15; *(LAS v4u*)(F.lds + key * RSV + ch * 16) = st[i]; } }
        float m = -INFINITY;
#pragma unroll
        for (int kb = 0; kb < 8; ++kb)
#pragma unroll
            for (int r = 0; r < 16; ++r) m = fmaxf(m, sa[kb][r]);
        m = xhalf_max(m);
        float lsum = 0.f; unsigned pk[8][8];
#pragma unroll
        for (int kb = 0; kb < 8; ++kb) {
#pragma unroll
            for (int r = 0; r < 16; ++r) { sa[kb][r] = __builtin_amdgcn_exp2f((sa[kb][r] - m) * C2); lsum += sa[kb][r]; }
#pragma unroll
            for (int r = 0; r < 8; ++r) pk[kb][r] = pkbf2(sa[kb][2 * r], sa[kb][2 * r + 1]); }
        lsum = xhalf_sum(lsum);
        const float inv = 1.f / lsum;
        __syncthreads();
        const int g = lane >> 4, i16 = lane & 15;
        const LAS unsigned char* vb = F.lds + (4 * (g >> 1) + (i16 >> 2)) * RSV + (16 * (g & 1) + 4 * (i16 & 3)) * 2;
        f32x16 o[4];
#pragma unroll
        for (int d = 0; d < 4; ++d) o[d] = (f32x16){};
#pragma unroll
        for (int kb = 0; kb < 8; ++kb)
#pragma unroll
            for (int s2 = 0; s2 < 2; ++s2) { const pg8::bf16x8 pb = __builtin_bit_cast(pg8::bf16x8, (v4u){pk[kb][4 * s2], pk[kb][4 * s2 + 1], pk[kb][4 * s2 + 2], pk[kb][4 * s2 + 3]});
#pragma unroll
                for (int d = 0; d < 4; ++d) { const LAS unsigned char* vp = vb + (kb * 32 + 16 * s2) * RSV + d * 64;
                    const pg8::bf16x8 vf = cat8(vtr(vp), vtr(vp + 8 * RSV));
                    o[d] = __builtin_amdgcn_mfma_f32_32x32x16_bf16(vf, pb, o[d], 0, 0, 0); } }
#pragma unroll
        for (int d = 0; d < 4; ++d)
#pragma unroll
            for (int j = 0; j < 2; ++j) {
                const unsigned ax = pkbf2(o[d][8 * j] * inv, o[d][8 * j + 1] * inv), ay = pkbf2(o[d][8 * j + 2] * inv, o[d][8 * j + 3] * inv);
                const unsigned bx = pkbf2(o[d][8 * j + 4] * inv, o[d][8 * j + 5] * inv), by = pkbf2(o[d][8 * j + 6] * inv, o[d][8 * j + 7] * inv);
                const auto sx = __builtin_amdgcn_permlane32_swap(ax, bx, false, false), sy = __builtin_amdgcn_permlane32_swap(ay, by, false, false);
                v4u w; w.x = sx[0]; w.y = sy[0]; w.z = sx[1]; w.w = sy[1];
                *(GAS v4u*)(OX + (size_t)qrow * 512 + h * 128 + d * 32 + 8 * (2 * j + h5)) = w; }
        __syncthreads();
    }
}
constexpr size_t WS_MLGS = WS_FCUM;
constexpr size_t WS_MLBC = WS_FCUM + 256 * 1024;
constexpr size_t WS_MLN = WS_EXT;
constexpr size_t WS_MLG = WS_EXT + 1 * MiB;
constexpr size_t WS_MLC = WS_WB;
static_assert(WB_ODIN * 2 >= 16 * MiB, "C_loc overlays only layer-0 weights");
__device__ __forceinline__ float wave_incl_scan_add(float v, int lane) {
#pragma unroll
    for (int o = 1; o < 64; o <<= 1) { const float t = __shfl_up(v, o); if (lane >= o) v += t; }
    return v;
}
__device__ __forceinline__ float wave_incl_scan_max(float v, int lane) {
#pragma unroll
    for (int o = 1; o < 64; o <<= 1) { const float t = __shfl_up(v, o); if (lane >= o) v = fmaxf(v, t); }
    return v;
}
__device__ __forceinline__ float wave_max(float v) {
#pragma unroll
    for (int o = 1; o < 64; o <<= 1) v = fmaxf(v, __shfl_xor(v, o));
    return v;
}
template <int PASS> __device__ __forceinline__ void mlstm_phase(Frame& F, const Args& args, int u_first, int u_stride) {
    constexpr int RSV = 320, RSC = 272;
    constexpr float SCL = 0.08838834764831845f, L2E = 1.4426950408889634f;
    unsigned char* ws = args.ws; const bf16_t* Z1 = (const bf16_t*)(ws + WS_Z); const float* GATES = (const float*)(ws + WS_GATES);
    float* GS = (float*)(ws + WS_MLGS); float* BC = (float*)(ws + WS_MLBC); float* NL = (float*)(ws + WS_MLN); float* MG = (float*)(ws + WS_MLG); bf16_t* CL = (bf16_t*)(ws + WS_MLC);
    bf16_t* YM = (bf16_t*)(ws + WS_YMIX); const float* normg = args.in[19];
    int tid = threadIdx.x; asm volatile("" : "+v"(tid));
    const int lane = tid & 63, wave = __builtin_amdgcn_readfirstlane(tid >> 6), r32 = lane & 31, h5 = lane >> 5;
    const int g16 = lane >> 4, i16 = lane & 15;
    LAS unsigned char* const lds = F.lds;
    if constexpr (PASS == 0) {
        LAS float* warr = (LAS float*)(lds + 81920); LAS float* wtot = (LAS float*)(lds + 81920 + 1024); LAS float* npart = (LAS float*)(lds + 81920 + 2048);
        const int tro = (8 * (g16 >> 1) + (i16 >> 2)) * RSV + (16 * (g16 & 1) + 4 * (i16 & 3)) * 2;
        for (int u = u_first; u < 256; u += u_stride) {
            const int bh = u >> 4, c = u & 15, b = bh >> 2, h = bh & 3; const size_t row0 = (size_t)b * SEQ + c * 256;
            float lf = 0.f, ig = 0.f, sc = 0.f;
            if (tid < 256) { const float f = GATES[(row0 + tid) * 8 + 4 + h]; ig = GATES[(row0 + tid) * 8 + h]; lf = fminf(f, 0.f) - log1pf(__expf(-fabsf(f))); sc = wave_incl_scan_add(lf, lane); if (lane == 63) wtot[wave] = sc; }
            __syncthreads();
            const float t0 = wtot[0], t1 = wtot[1], t2 = wtot[2], t3 = wtot[3], gtot = (t0 + t1) + (t2 + t3);
            float a = -INFINITY, bcum = 0.f;
            if (tid < 256) { bcum = sc + (wave > 0 ? t0 : 0.f) + (wave > 1 ? t1 : 0.f) + (wave > 2 ? t2 : 0.f); a = gtot - bcum + ig; const float wm = wave_max(a); if (lane == 0) wtot[4 + wave] = wm;
                GS[(size_t)h * MTOK + row0 + tid] = ig - bcum; BC[(size_t)h * MTOK + row0 + tid] = bcum; }
            __syncthreads();
            const float mloc = fmaxf(fmaxf(wtot[4], wtot[5]), fmaxf(wtot[6], wtot[7]));
            if (tid < 256) warr[tid] = __expf(a - mloc);
            if (tid == 0) { MG[u * 2] = mloc; MG[u * 2 + 1] = gtot; }
            f32x16 acc[2]; acc[0] = (f32x16){}; acc[1] = (f32x16){};
            float np = 0.f;
            const int vb = wave >> 1, kb0 = (wave & 1) * 2;
#pragma unroll 1
            for (int half = 0; half < 2; ++half) {
                __syncthreads();
                { v4u kst[4], vst[4];
#pragma unroll
                  for (int i = 0; i < 4; ++i) { const int cc = tid + 512 * i, rr = cc >> 4, ch = cc & 15; const size_t grow = row0 + half * 128 + rr;
                      kst[i] = *(const GAS v4u*)(Z1 + grow * 2816 + 512 + h * 128 + ch * 8); vst[i] = *(const GAS v4u*)(Z1 + grow * 2816 + 1024 + h * 128 + ch * 8); }
#pragma unroll
                  for (int i = 0; i < 4; ++i) { const int cc = tid + 512 * i, rr = cc >> 4, ch = cc & 15;
                      *(LAS v4u*)(lds + rr * RSV + ch * 16) = kst[i];
                      float vv[8]; unpack8(vst[i], vv); const float w = warr[half * 128 + rr];
                      v4u o; o.x = pkbf2(vv[0] * w, vv[1] * w); o.y = pkbf2(vv[2] * w, vv[3] * w); o.z = pkbf2(vv[4] * w, vv[5] * w); o.w = pkbf2(vv[6] * w, vv[7] * w);
                      *(LAS v4u*)(lds + 40960 + rr * RSV + ch * 16) = o; } }
                __syncthreads();
#pragma unroll
                for (int ks = 0; ks < 8; ++ks) { const LAS unsigned char* vp = lds + 40960 + tro + 16 * ks * RSV + vb * 64;
                    const pg8::bf16x8 af = cat8(vtr(vp), vtr(vp + 4 * RSV));
#pragma unroll
                    for (int j = 0; j < 2; ++j) { const LAS unsigned char* kp = lds + tro + 16 * ks * RSV + (kb0 + j) * 64;
                        const pg8::bf16x8 bf = cat8(vtr(kp), vtr(kp + 4 * RSV));
                        acc[j] = __builtin_amdgcn_mfma_f32_32x32x16_bf16(af, bf, acc[j], 0, 0, 0); } }
                { const int k = tid & 127, sq = tid >> 7;
#pragma unroll 8
                  for (int rr = 0; rr < 32; ++rr) { const int s_ = sq * 32 + rr; const unsigned short kv = *(const LAS unsigned short*)(lds + s_ * RSV + k * 2); np += warr[half * 128 + s_] * __uint_as_float(((unsigned)kv) << 16); } }
            }
            npart[tid] = np;
            bf16_t* cl = CL + (size_t)u * 16384;
#pragma unroll
            for (int j = 0; j < 2; ++j)
#pragma unroll
                for (int r = 0; r < 16; ++r) cl[(size_t)(vb * 32 + (r & 3) + 8 * (r >> 2) + 4 * h5) * 128 + (kb0 + j) * 32 + r32] = (bf16_t)(pkbf2(acc[j][r] * SCL, 0.f) & 0xffffu);
            __syncthreads();
            if (tid < 128) NL[(size_t)u * 128 + tid] = ((npart[tid] + npart[128 + tid]) + (npart[256 + tid] + npart[384 + tid])) * SCL;
            __syncthreads();
        }
    }
    if constexpr (PASS == 1) {
        LAS unsigned char* const Cl = lds + 81920;
        LAS float* gsl = (LAS float*)(lds + 125440); LAS float* Mtl = (LAS float*)(lds + 126464); LAS float* bcl = (LAS float*)(lds + 127488); LAS float* wtot = (LAS float*)(lds + 128512);
        const int vbo = (4 * (g16 >> 1) + (i16 >> 2)) * RSV + (16 * (g16 & 1) + 4 * (i16 & 3)) * 2;
        for (int u = u_first; u < 256; u += u_stride) {
            const int bh = u >> 4, c = u & 15, b = bh >> 2, h = bh & 3; const size_t row0 = (size_t)b * SEQ + c * 256;
            float mprev = -INFINITY;
            { float ml[16], gt[16];
#pragma unroll
              for (int cp = 0; cp < 16; ++cp) { const v2u mg = *(const GAS v2u*)(MG + (bh * 16 + cp) * 2); ml[cp] = __uint_as_float(mg.x); gt[cp] = __uint_as_float(mg.y); }
              float G = 0.f;
#pragma unroll
              for (int cp = 15; cp >= 0; --cp) if (cp < c) { mprev = fmaxf(mprev, G + ml[cp]); G += gt[cp]; }
              G = 0.f; float mine = 0.f;
#pragma unroll
              for (int cp = 15; cp >= 0; --cp) if (cp < c) { const float e = __expf(G + ml[cp] - mprev); G += gt[cp]; if (tid == cp) mine = e; }
              if (tid < 16) wtot[16 + tid] = mine; }
            __syncthreads();
            { f32x4 a4[8];
#pragma unroll
              for (int i = 0; i < 8; ++i) a4[i] = (f32x4){0.f, 0.f, 0.f, 0.f};
              f32x4 n4 = (f32x4){0.f, 0.f, 0.f, 0.f};
              v4u cA[4], cB[4]; f32x4 nA, nB;
#define MLC_LOAD(S, NV, cp_) do { const int cq_ = (cp_) > 0 ? (cp_) : 0; const bf16_t* cl_ = CL + (size_t)(bh * 16 + cq_) * 16384; \
                  _Pragma("unroll") for (int i = 0; i < 4; ++i) S[i] = *(const GAS v4u*)(cl_ + tid * 8 + 4096 * i); \
                  NV = *(const GAS f32x4*)(NL + (size_t)(bh * 16 + cq_) * 128 + (tid & 31) * 4); } while (0)
#define MLC_ACC(S, NV, e_) do { _Pragma("unroll") for (int i = 0; i < 4; ++i) { float f8[8]; unpack8(S[i], f8); \
                      a4[2 * i] += (f32x4){f8[0], f8[1], f8[2], f8[3]} * (e_); a4[2 * i + 1] += (f32x4){f8[4], f8[5], f8[6], f8[7]} * (e_); } \
                  n4 += NV * (e_); } while (0)
              MLC_LOAD(cA, nA, c - 1); MLC_LOAD(cB, nB, c - 2);
              for (int cp = c - 1; cp >= 0; cp -= 2) {
                  const float eA = wtot[16 + cp], eB = (cp >= 1) ? wtot[16 + (cp >= 1 ? cp - 1 : 0)] : 0.f;
                  MLC_ACC(cA, nA, eA); MLC_LOAD(cA, nA, cp - 2);
                  MLC_ACC(cB, nB, eB); MLC_LOAD(cB, nB, cp - 3); }
#undef MLC_LOAD
#undef MLC_ACC
#pragma unroll
              for (int i = 0; i < 4; ++i) { const int e0 = tid * 8 + 4096 * i, v = e0 >> 7, k = e0 & 127; v4u w; w.x = pkbf2(a4[2 * i][0], a4[2 * i][1]); w.y = pkbf2(a4[2 * i][2], a4[2 * i][3]); w.z = pkbf2(a4[2 * i + 1][0], a4[2 * i + 1][1]); w.w = pkbf2(a4[2 * i + 1][2], a4[2 * i + 1][3]);
                  *(LAS v4u*)(Cl + v * RSC + k * 2) = w; }
              if (tid < 32) { v2u w; w.x = pkbf2(n4[0], n4[1]); w.y = pkbf2(n4[2], n4[3]); *(LAS v2u*)(Cl + 128 * RSC + tid * 8) = w; }
              for (int e0 = tid; e0 < 31 * 32; e0 += 512) { const int v = 129 + e0 / 32, k4 = e0 % 32; *(LAS v2u*)(Cl + v * RSC + k4 * 8) = (v2u){0u, 0u}; } }
            { v4u st[8];
#pragma unroll
              for (int i = 0; i < 8; ++i) { const int cc = tid + 512 * i, rr = cc >> 4, ch = cc & 15; st[i] = *(const GAS v4u*)(Z1 + (row0 + rr) * 2816 + 1024 + h * 128 + ch * 8); }
#pragma unroll
              for (int i = 0; i < 8; ++i) { const int cc = tid + 512 * i, rr = cc >> 4, ch = cc & 15; *(LAS v4u*)(lds + rr * RSV + ch * 16) = st[i]; } }
            const int tl = wave * 32 + r32; const size_t row = row0 + tl;
            pg8::bf16x8 qf[8];
#pragma unroll
            for (int kd = 0; kd < 8; ++kd) qf[kd] = *(const pg8::bf16x8*)(Z1 + row * 2816 + h * 128 + kd * 16 + 8 * h5);
            float pm = -INFINITY;
            if (tid < 256) { const float gsv = GS[(size_t)h * MTOK + row0 + tid]; gsl[tid] = gsv; bcl[tid] = BC[(size_t)h * MTOK + row0 + tid]; pm = wave_incl_scan_max(gsv, lane); if (lane == 63) wtot[wave] = pm; }
            __syncthreads();
            if (tid < 256) { float off = mprev; if (wave > 0) off = fmaxf(off, wtot[0]); if (wave > 1) off = fmaxf(off, wtot[1]); if (wave > 2) off = fmaxf(off, wtot[2]); Mtl[tid] = fmaxf(pm, off); }
            __syncthreads();
            const float Mt = Mtl[tl]; const float winter = __builtin_amdgcn_exp2f((mprev - Mt) * L2E);
            f32x16 o[4]; float dinter;
            { f32x16 o4 = (f32x16){};
#pragma unroll
              for (int d = 0; d < 4; ++d) o[d] = (f32x16){};
#pragma unroll
              for (int kd = 0; kd < 8; ++kd) {
#pragma unroll
                  for (int d = 0; d < 4; ++d) { const pg8::bf16x8 cf = *(const LAS pg8::bf16x8*)(Cl + (d * 32 + r32) * RSC + (kd * 16 + 8 * h5) * 2); o[d] = __builtin_amdgcn_mfma_f32_32x32x16_bf16(cf, qf[kd], o[d], 0, 0, 0); }
                  const pg8::bf16x8 cf = *(const LAS pg8::bf16x8*)(Cl + (128 + r32) * RSC + (kd * 16 + 8 * h5) * 2); o4 = __builtin_amdgcn_mfma_f32_32x32x16_bf16(cf, qf[kd], o4, 0, 0, 0); }
#pragma unroll
              for (int d = 0; d < 4; ++d)
#pragma unroll
                  for (int r = 0; r < 16; ++r) o[d][r] *= winter;
              dinter = xhalf_sum(o4[0]) * winter; }
            float dintra = 0.f;
            pg8::bf16x8 kfa[8], kfb[8];
            { const bf16_t* kg = Z1 + (row0 + r32) * 2816 + 512 + h * 128 + 8 * h5;
#pragma unroll
              for (int kd = 0; kd < 8; ++kd) kfa[kd] = *(const pg8::bf16x8*)(kg + kd * 16); }
#pragma unroll 1
            for (int sb = 0; sb <= wave; ++sb) {
                f32x16 sa = (f32x16){};
                { const int sn = (sb + 1 <= wave) ? sb + 1 : sb; const bf16_t* kg = Z1 + (row0 + sn * 32 + r32) * 2816 + 512 + h * 128 + 8 * h5;
#pragma unroll
                  for (int kd = 0; kd < 8; ++kd) kfb[kd] = *(const pg8::bf16x8*)(kg + kd * 16); }
#pragma unroll
                for (int kd = 0; kd < 8; ++kd) sa = __builtin_amdgcn_mfma_f32_32x32x16_bf16(kfa[kd], qf[kd], sa, 0, 0, 0);
#pragma unroll
                for (int gq = 0; gq < 4; ++gq) { const int sbase = sb * 32 + 8 * gq + 4 * h5; const f32x4 g4 = *(const LAS f32x4*)(gsl + sbase);
#pragma unroll
                    for (int e = 0; e < 4; ++e) { const int r = 4 * gq + e; float wgt = __builtin_amdgcn_exp2f((g4[e] - Mt) * L2E) * SCL; if (sbase + e > tl) wgt = 0.f; sa[r] *= wgt; dintra += sa[r]; } }
#pragma unroll
                for (int s2 = 0; s2 < 2; ++s2) { const pg8::bf16x8 pb = __builtin_bit_cast(pg8::bf16x8, (v4u){pkbf2(sa[8 * s2], sa[8 * s2 + 1]), pkbf2(sa[8 * s2 + 2], sa[8 * s2 + 3]), pkbf2(sa[8 * s2 + 4], sa[8 * s2 + 5]), pkbf2(sa[8 * s2 + 6], sa[8 * s2 + 7])});
#pragma unroll
                    for (int d = 0; d < 4; ++d) { const LAS unsigned char* vp = lds + vbo + (sb * 32 + 16 * s2) * RSV + d * 64; const pg8::bf16x8 vf = cat8(vtr(vp), vtr(vp + 8 * RSV));
                        o[d] = __builtin_amdgcn_mfma_f32_32x32x16_bf16(vf, pb, o[d], 0, 0, 0); } }
#pragma unroll
                for (int kd = 0; kd < 8; ++kd) kfa[kd] = kfb[kd];
            }
            const float denr = dinter + xhalf_sum(dintra); const float mt = bcl[tl] + Mt; const float inv = 1.f / fmaxf(fabsf(denr), __expf(-mt));
            float ss = 0.f;
            { v2u og[4][4];
#pragma unroll
              for (int d = 0; d < 4; ++d)
#pragma unroll
                  for (int gq = 0; gq < 4; ++gq) og[d][gq] = *(const GAS v2u*)(Z1 + row * 2816 + 1536 + h * 128 + d * 32 + 8 * gq + 4 * h5);
#pragma unroll
              for (int d = 0; d < 4; ++d)
#pragma unroll
                  for (int gq = 0; gq < 4; ++gq) { const float g0 = bflo(og[d][gq].x), g1 = bfhi(og[d][gq].x), g2 = bflo(og[d][gq].y), g3 = bfhi(og[d][gq].y);
                      o[d][4 * gq] = o[d][4 * gq] * inv / (1.f + __expf(-g0)); o[d][4 * gq + 1] = o[d][4 * gq + 1] * inv / (1.f + __expf(-g1));
                      o[d][4 * gq + 2] = o[d][4 * gq + 2] * inv / (1.f + __expf(-g2)); o[d][4 * gq + 3] = o[d][4 * gq + 3] * inv / (1.f + __expf(-g3));
                      ss += (o[d][4 * gq] * o[d][4 * gq] + o[d][4 * gq + 1] * o[d][4 * gq + 1]) + (o[d][4 * gq + 2] * o[d][4 * gq + 2] + o[d][4 * gq + 3] * o[d][4 * gq + 3]); } }
            const float rstd = rsqrtf(xhalf_sum(ss) * (1.f / 128.f) + 1e-6f);
#pragma unroll
            for (int d = 0; d < 4; ++d) { f32x4 gn[4];
#pragma unroll
                for (int gq = 0; gq < 4; ++gq) gn[gq] = *(const GAS f32x4*)(normg + h * 128 + d * 32 + 8 * gq + 4 * h5);
#pragma unroll
                for (int gq = 0; gq < 4; ++gq) { const int v0 = h * 128 + d * 32 + 8 * gq + 4 * h5;
                    v2u w; w.x = pkbf2(o[d][4 * gq] * rstd * gn[gq][0], o[d][4 * gq + 1] * rstd * gn[gq][1]); w.y = pkbf2(o[d][4 * gq + 2] * rstd * gn[gq][2], o[d][4 * gq + 3] * rstd * gn[gq][3]);
                    *(GAS v2u*)(YM + row * 1024 + v0) = w; } }
            __syncthreads();
        }
    }
}
__device__ __forceinline__ float max3f_(float a, float b, float c) { float r; asm("v_max3_f32 %0, %1, %2, %3" : "=v"(r) : "v"(a), "v"(b), "v"(c)); return r; }
__device__ __forceinline__ float max2f_(float a, float b) { float r; asm("v_max_f32_e32 %0, %1, %2" : "=v"(r) : "v"(a), "v"(b)); return r; }
__device__ __forceinline__ float fadd_(float a, float b) { float r; asm("v_add_f32_e32 %0, %1, %2" : "=v"(r) : "v"(a), "v"(b)); return r; }
template <int ABL> __device__ __forceinline__ void mla_attn_phase(Frame& F, const Args& args, bf16_t* YM, int ldy) {
    constexpr int RSK = 208, RSV = 192, KB = 128 * RSK, VB = 128 * RSV, SLOT = KB + VB;
    unsigned char* ws = args.ws; const bf16_t* QM = (const bf16_t*)args.out  ; const bf16_t* KM = QM + (size_t)MTOK * 768; const bf16_t* VM = KM + (size_t)MTOK * 768;
    int tid = threadIdx.x; asm volatile("" : "+v"(tid));
    const int lane = tid & 63, wave = __builtin_amdgcn_readfirstlane(tid >> 6), r32 = lane & 31, h5 = lane >> 5;
    const float C2 = 0.10206207261596575f * 1.4426950408889634f;
    const int g = lane >> 4, i16 = lane & 15;
    const int vboff = (4 * (g >> 1) + (i16 >> 2)) * RSV + (16 * (g & 1) + 4 * (i16 & 3)) * 2;
    int kgo[3], klo[3];
#pragma unroll
    for (int i = 0; i < 3; ++i) { const int id = tid + 512 * i, key = id / 12, ch = id % 12; kgo[i] = key * 768 + ch * 8; klo[i] = key * RSK + ch * 16; }
#define VGO(i) (((tid + 512 * (i)) >> 3) * 512 + ((tid + 512 * (i)) & 7) * 8)
#define VLO(i) (KB + ((tid + 512 * (i)) >> 3) * RSV + ((tid + 512 * (i)) & 7) * 16)
    if (wave < 4) __builtin_amdgcn_s_setprio(2);
    for (int pid = F.vcu; pid < 256; pid += F.G) {
        const int bh = pid >> 3, b = bh >> 3, h = bh & 7;
#pragma unroll 1
        for (int half = 0; half < 2; ++half) {
            const int qb = half ? 15 - (pid & 7) : (pid & 7);
            const int q0w = qb * 256 + wave * 32, NT = 2 * qb + 2;
            const size_t rowb = (size_t)b * SEQ;
            const bf16_t* Kg = KM + rowb * 768 + h * 96; const bf16_t* Vg = VM + rowb * 512 + h * 64;
            pg8::bf16x8 qf[6];
#pragma unroll
            for (int kd = 0; kd < 6; ++kd) { const v4u raw = *(const GAS v4u*)(QM + (rowb + q0w + r32) * 768 + h * 96 + kd * 16 + 8 * h5); float f8[8]; unpack8(raw, f8);
                v4u w; w.x = pkbf2(f8[0] * C2, f8[1] * C2); w.y = pkbf2(f8[2] * C2, f8[3] * C2); w.z = pkbf2(f8[4] * C2, f8[5] * C2); w.w = pkbf2(f8[6] * C2, f8[7] * C2); qf[kd] = __builtin_bit_cast(pg8::bf16x8, w); }
            v4u sA[5];
#define MLA_LOAD(S, t) do { const bf16_t* kt = Kg + (size_t)(t) * 128 * 768; const bf16_t* vt = Vg + (size_t)(t) * 128 * 512; \
            S[0] = *(const GAS v4u*)(kt + kgo[0]); S[1] = *(const GAS v4u*)(kt + kgo[1]); S[2] = *(const GAS v4u*)(kt + kgo[2]); S[3] = *(const GAS v4u*)(vt + VGO(0)); S[4] = *(const GAS v4u*)(vt + VGO(1)); } while (0)
#define MLA_STORE(S, buf) do { LAS unsigned char* b_ = F.lds + (buf) * SLOT; \
            *(LAS v4u*)(b_ + klo[0]) = S[0]; *(LAS v4u*)(b_ + klo[1]) = S[1]; *(LAS v4u*)(b_ + klo[2]) = S[2]; *(LAS v4u*)(b_ + VLO(0)) = S[3]; *(LAS v4u*)(b_ + VLO(1)) = S[4]; } while (0)
            float mref = 0.f, lsum = 0.f; f32x16 o[2]; o[0] = (f32x16){}; o[1] = (f32x16){}; f32x16 negm = (f32x16){}; bool first = true;
#define MLA_SUB(kbp, vbp, kbase) do { if ((kbase) <= q0w + 31) { \
                f32x16 s0 = negm, s1 = negm; \
                pg8::bf16x8 kf[12]; \
                if (!(ABL & 4)) { \
                _Pragma("unroll") for (int kd = 0; kd < 6; ++kd) { kf[2 * kd] = *(const LAS pg8::bf16x8*)((kbp) + r32 * RSK + (kd * 16 + 8 * h5) * 2); kf[2 * kd + 1] = *(const LAS pg8::bf16x8*)((kbp) + (32 + r32) * RSK + (kd * 16 + 8 * h5) * 2); } \
                __builtin_amdgcn_sched_barrier(0); \
                _Pragma("unroll") for (int kd = 0; kd < 6; ++kd) { s0 = __builtin_amdgcn_mfma_f32_32x32x16_bf16(kf[2 * kd], qf[kd], s0, 0, 0, 0); s1 = __builtin_amdgcn_mfma_f32_32x32x16_bf16(kf[2 * kd + 1], qf[kd], s1, 0, 0, 0); } } \
                s16x4 vl[8], vh[8]; \
                if (!(ABL & 2)) _Pragma("unroll") for (int ks = 0; ks < 4; ++ks) _Pragma("unroll") for (int d = 0; d < 2; ++d) { const LAS unsigned char* vp = (vbp) + vboff + (16 * ks) * RSV + d * 64; vl[2 * ks + d] = vtr(vp); vh[2 * ks + d] = vtr(vp + 8 * RSV); } \
                __builtin_amdgcn_sched_barrier(0); \
                if ((kbase) + 63 > q0w) { const int q = q0w + r32, k0i = (kbase) + 4 * h5; \
                    _Pragma("unroll") for (int r = 0; r < 16; ++r) { const int kv = k0i + (r & 3) + 8 * (r >> 2); if (kv > q) s0[r] = -INFINITY; if (kv + 32 > q) s1[r] = -INFINITY; } } \
                if (!(ABL & 1)) { \
                asm volatile("s_nop 15\n\ts_nop 7" : "+v"(s0), "+v"(s1));     \
                float mxa = max3f_(s0[0], s0[1], s1[0]), mxb = max3f_(s0[2], s0[3], s1[1]); mxa = max3f_(mxa, s1[2], s1[3]); \
                _Pragma("unroll") for (int r = 4; r < 16; r += 4) { mxa = max3f_(mxa, s0[r], s0[r + 1]); mxb = max3f_(mxb, s0[r + 2], s0[r + 3]); mxa = max3f_(mxa, s1[r], s1[r + 1]); mxb = max3f_(mxb, s1[r + 2], s1[r + 3]); } \
                float mx = xhalf_max(fmaxf(mxa, mxb));     \
                if (first || __any(mx > 8.0f)) { const float dl = first ? mx : fmaxf(mx, 0.f); first = false; mref += dl; const float alpha = __builtin_amdgcn_exp2f(-dl); lsum *= alpha; \
                    _Pragma("unroll") for (int r = 0; r < 16; ++r) { s0[r] -= dl; s1[r] -= dl; o[0][r] *= alpha; o[1][r] *= alpha; negm[r] = -mref; } } \
                float pa_ = 0.f, pb_ = 0.f, pc_ = 0.f, pd_ = 0.f; \
                _Pragma("unroll") for (int r = 0; r < 16; ++r) { s0[r] = __builtin_amdgcn_exp2f(s0[r]); s1[r] = __builtin_amdgcn_exp2f(s1[r]); } \
                _Pragma("unroll") for (int r = 0; r < 16; r += 2) { pa_ += s0[r]; pb_ += s0[r + 1]; pc_ += s1[r]; pd_ += s1[r + 1]; asm volatile("" : "+v"(pa_), "+v"(pb_), "+v"(pc_), "+v"(pd_)); }     \
                lsum += (pa_ + pb_) + (pc_ + pd_); } else { lsum += s0[0] + s1[5]; } \
                pg8::bf16x8 pb[4]; \
                _Pragma("unroll") for (int s2 = 0; s2 < 2; ++s2) { \
                    pb[s2] = __builtin_bit_cast(pg8::bf16x8, (v4u){pkbf2(s0[8 * s2], s0[8 * s2 + 1]), pkbf2(s0[8 * s2 + 2], s0[8 * s2 + 3]), pkbf2(s0[8 * s2 + 4], s0[8 * s2 + 5]), pkbf2(s0[8 * s2 + 6], s0[8 * s2 + 7])}); \
                    pb[2 + s2] = __builtin_bit_cast(pg8::bf16x8, (v4u){pkbf2(s1[8 * s2], s1[8 * s2 + 1]), pkbf2(s1[8 * s2 + 2], s1[8 * s2 + 3]), pkbf2(s1[8 * s2 + 4], s1[8 * s2 + 5]), pkbf2(s1[8 * s2 + 6], s1[8 * s2 + 7])}); } \
                if (!(ABL & 2)) { _Pragma("unroll") for (int ks = 0; ks < 4; ++ks) \
                    _Pragma("unroll") for (int d = 0; d < 2; ++d) o[d] = __builtin_amdgcn_mfma_f32_32x32x16_bf16(cat8(vl[2 * ks + d], vh[2 * ks + d]), pb[ks], o[d], 0, 0, 0); } \
                else { asm volatile("" :: "v"(pb[0]), "v"(pb[1]), "v"(pb[2]), "v"(pb[3])); } } } while (0)
#define MLA_TILE(t, buf) do { const LAS unsigned char* kb_ = F.lds + (buf) * SLOT; const LAS unsigned char* vb_ = kb_ + KB; \
                MLA_SUB(kb_, vb_, 128 * (t)); MLA_SUB(kb_ + 64 * RSK, vb_ + 64 * RSV, 128 * (t) + 64); } while (0)
#define MLA_QK(S0, S1, kbp) do { pg8::bf16x8 kf[12]; \
                _Pragma("unroll") for (int kd = 0; kd < 6; ++kd) { kf[2 * kd] = *(const LAS pg8::bf16x8*)((kbp) + r32 * RSK + (kd * 16 + 8 * h5) * 2); kf[2 * kd + 1] = *(const LAS pg8::bf16x8*)((kbp) + (32 + r32) * RSK + (kd * 16 + 8 * h5) * 2); } \
                _Pragma("unroll") for (int kd = 0; kd < 6; ++kd) { S0 = __builtin_amdgcn_mfma_f32_32x32x16_bf16(kf[2 * kd], qf[kd], S0, 0, 0, 0); S1 = __builtin_amdgcn_mfma_f32_32x32x16_bf16(kf[2 * kd + 1], qf[kd], S1, 0, 0, 0); } } while (0)
#define MLA_SM(S0, S1, PB) do { float mx = fmaxf(S0[0], S1[0]); \
                _Pragma("unroll") for (int r = 1; r < 16; ++r) mx = fmaxf(mx, fmaxf(S0[r], S1[r])); \
                mx = xhalf_max(mx) * C2; \
                const float mn = fmaxf(m, mx), alpha = __builtin_amdgcn_exp2f(m - mn); m = mn; \
                _Pragma("unroll") for (int r = 0; r < 16; ++r) { o[0][r] *= alpha; o[1][r] *= alpha; } \
                float ps = 0.f; \
                _Pragma("unroll") for (int r = 0; r < 16; ++r) { S0[r] = __builtin_amdgcn_exp2f(fmaf(S0[r], C2, -mn)); S1[r] = __builtin_amdgcn_exp2f(fmaf(S1[r], C2, -mn)); ps += S0[r] + S1[r]; } \
                lsum = lsum * alpha + ps; \
                _Pragma("unroll") for (int s2 = 0; s2 < 2; ++s2) { \
                    PB[s2] = __builtin_bit_cast(pg8::bf16x8, (v4u){pkbf2(S0[8 * s2], S0[8 * s2 + 1]), pkbf2(S0[8 * s2 + 2], S0[8 * s2 + 3]), pkbf2(S0[8 * s2 + 4], S0[8 * s2 + 5]), pkbf2(S0[8 * s2 + 6], S0[8 * s2 + 7])}); \
                    PB[2 + s2] = __builtin_bit_cast(pg8::bf16x8, (v4u){pkbf2(S1[8 * s2], S1[8 * s2 + 1]), pkbf2(S1[8 * s2 + 2], S1[8 * s2 + 3]), pkbf2(S1[8 * s2 + 4], S1[8 * s2 + 5]), pkbf2(S1[8 * s2 + 6], S1[8 * s2 + 7])}); } } while (0)
#define MLA_PV(PB, vbp) do { _Pragma("unroll") for (int ks = 0; ks < 4; ++ks) _Pragma("unroll") for (int d = 0; d < 2; ++d) { const LAS unsigned char* vp = (vbp) + vboff + (16 * ks) * RSV + d * 64; \
                o[d] = __builtin_amdgcn_mfma_f32_32x32x16_bf16(cat8(vtr(vp), vtr(vp + 8 * RSV)), PB[ks], o[d], 0, 0, 0); } } while (0)
#define MLA_FULL(buf) do { const LAS unsigned char* kb_ = F.lds + (buf) * SLOT; const LAS unsigned char* vb_ = kb_ + KB; \
                f32x16 a0 = (f32x16){}, a1 = (f32x16){}, b0 = (f32x16){}, b1 = (f32x16){}; pg8::bf16x8 pa[4], pbb[4]; \
                MLA_QK(a0, a1, kb_); \
                __builtin_amdgcn_sched_barrier(0); \
                MLA_QK(b0, b1, kb_ + 64 * RSK); MLA_SM(a0, a1, pa); \
                _Pragma("unroll") for (int i_ = 0; i_ < 12; ++i_) { __builtin_amdgcn_sched_group_barrier(0x100, 1, 0); __builtin_amdgcn_sched_group_barrier(0x8, 1, 0); __builtin_amdgcn_sched_group_barrier(0x2, 14, 0); } \
                __builtin_amdgcn_sched_barrier(0); \
                MLA_PV(pa, vb_); MLA_SM(b0, b1, pbb); \
                _Pragma("unroll") for (int i_ = 0; i_ < 8; ++i_) { __builtin_amdgcn_sched_group_barrier(0x100, 2, 1); __builtin_amdgcn_sched_group_barrier(0x8, 1, 1); __builtin_amdgcn_sched_group_barrier(0x2, 22, 1); } \
                __builtin_amdgcn_sched_barrier(0); \
                MLA_PV(pbb, vb_ + 64 * RSV); \
                __builtin_amdgcn_sched_barrier(0); } while (0)
            MLA_LOAD(sA, 0);
#pragma unroll
            for (int kd = 0; kd < 6; ++kd) asm volatile("" : "+v"(qf[kd]));
            MLA_STORE(sA, 0);
            __syncthreads();
            const int NFULL = 2 * qb;
#pragma unroll 1
            for (int t = 0; t < NT; ++t) {
                const int buf = t & 1;
                MLA_LOAD(sA, (t + 1 < NT ? t + 1 : NT - 1));
                MLA_TILE(t, buf); (void)NFULL;
                if (t + 1 < NT) MLA_STORE(sA, buf ^ 1);
                __syncthreads();
            }
            const float inv = 1.f / xhalf_sum(lsum);
#pragma unroll
            for (int d = 0; d < 2; ++d)
#pragma unroll
                for (int gq = 0; gq < 4; ++gq) { v2u w; w.x = pkbf2(o[d][4 * gq] * inv, o[d][4 * gq + 1] * inv); w.y = pkbf2(o[d][4 * gq + 2] * inv, o[d][4 * gq + 3] * inv);
                    *(GAS v2u*)(YM + (rowb + q0w + r32) * ldy + h * 64 + d * 32 + 8 * gq + 4 * h5) = w; }
#undef MLA_LOAD
#undef MLA_STORE
#undef MLA_SUB
#undef MLA_TILE
#undef MLA_QK
#undef MLA_SM
#undef MLA_PV
#undef MLA_FULL
#undef VGO
#undef VLO
        }
    }
    __builtin_amdgcn_s_setprio(0);
}
__device__ __forceinline__ void final_norm_phase(Frame& F, const Args& args, float tscale, float tadd) {
    int tid = threadIdx.x; asm volatile("" : "+v"(tid)); const int lane = tid & 63, wv = __builtin_amdgcn_readfirstlane(tid >> 6);
    const int gw = F.vcu * NWAVES + wv, NGW = F.G * NWAVES; const float* g = args.in[25]; float* X = args.out; const bf16_t* XB = (const bf16_t*)(args.ws + WS_XB);
    f32x4 gv[4];
#pragma unroll
    for (int j = 0; j < 4; ++j) gv[j] = ((const GAS f32x4*)g)[2 * lane + 128 * (j >> 1) + (j & 1)];
    for (int m = gw; m < MTOK; m += NGW) {
        const v4u r0 = __builtin_nontemporal_load((const GAS v4u*)(XB + (size_t)m * DM + 8 * lane)), r1 = __builtin_nontemporal_load((const GAS v4u*)(XB + (size_t)m * DM + 512 + 8 * lane));
        float a[8], b[8]; unpack8(r0, a); unpack8(r1, b); float s = 0.f;
#pragma unroll
        for (int e = 0; e < 8; ++e) s += a[e] * a[e] + b[e] * b[e];
        const float rs = rsqrtf(wave_sum(s) * (1.f / 1024.f) + 1e-6f) * tscale;
        GAS f32x4* xr = (GAS f32x4*)(X + (size_t)m * DM);
        f32x4 o0 = (f32x4){a[0], a[1], a[2], a[3]} * rs * gv[0], o1 = (f32x4){a[4], a[5], a[6], a[7]} * rs * gv[1], o2 = (f32x4){b[0], b[1], b[2], b[3]} * rs * gv[2], o3 = (f32x4){b[4], b[5], b[6], b[7]} * rs * gv[3];
        if (m == 0 && lane == 0) o0.x += tadd;
        xr[2 * lane] = o0; xr[2 * lane + 1] = o1; xr[128 + 2 * lane] = o2; xr[128 + 2 * lane + 1] = o3; }
}
constexpr int NPHASE = 20;
__global__ void __launch_bounds__(NWAVES * 64, 2) mega(Args args) {
    extern __shared__ __attribute__((aligned(16))) unsigned char lds[];
    Frame F;
    F.lds = (LAS unsigned char*)lds; F.MISC = (volatile LAS unsigned*)(F.lds + MISC_OFF);
    F.tid = threadIdx.x; F.lane = F.tid & 63; F.wave = __builtin_amdgcn_readfirstlane(F.tid >> 6);
    F.G = gridDim.x; { const int bx = blockIdx.x; F.vcu = (F.G % 8 == 0) ? (bx % 8) * (F.G / 8) + bx / 8 : bx; }
    unsigned char* ws = args.ws;
    F.ctl = (gu32*)(ws + WS_CTL);
    for (int u = F.tid; u < (LDS_BYTES - LDSCTL_OFF) / 4; u += NWAVES * 64) ((LAS unsigned*)(F.lds + LDSCTL_OFF))[u] = 0u;
    __syncthreads();
    XcdBarrier bar = xcd_barrier_post((unsigned*)(F.ctl + CW_BAR) + args.li * XCD_BAR_WORDS, F.MISC + 8);
    const int lo = args.ph_lo, hi = args.ph_hi;
#ifndef PHASES
#define PHASES 0xFFFFFu
#endif
#define IN(k) (((PHASES >> (k)) & 1u) && lo <= (k) && (k) < hi)
#ifndef DUP_MASK
#define DUP_MASK 0u
#endif
#define DUP(k) for (int rep_ = 0; rep_ < ((((DUP_MASK) >> (k)) & 1u) ? 2 : 1); ++rep_, (((((DUP_MASK) >> (k)) & 1u) && rep_ == 1) ? xcd_barrier(bar) : (void)0))
#ifdef TPROBE_LO
#define STAMP(k) do { if (blockIdx.x == 0 && F.tid == 0) TS[k] = __builtin_amdgcn_s_memrealtime(); } while (0)
#else
#define STAMP(k) do { } while (0)
#endif
#define SEAM(k) do { if (IN(k) && IN((k) + 1)) xcd_barrier(bar); STAMP((k) + 1); } while (0)
    bf16_t* const WB = (bf16_t*)(ws + WS_WB);
    bf16_t* const XB = (bf16_t*)(ws + WS_XB); bf16_t* const Z = (bf16_t*)(ws + WS_Z); bf16_t* const YMIX = (bf16_t*)(ws + WS_YMIX);
    float* const SSQ = (float*)(ws + WS_SSQ); float* const SSQ2 = (float*)(ws + WS_SSQ2);
    const int bid = (int)blockIdx.x;
#ifndef FUSE_FINAL
#define FUSE_FINAL 0
#endif
    const bool fuse_final = FUSE_FINAL && (F.G == 256) && IN(18) && IN(19);
    unsigned long long* const TS = (unsigned long long*)(ws + WS_CTL + 512 * 1024); (void)TS;
    STAMP(0);

    if (IN(0)) { DUP(0) p0_prologue(F, args); SEAM(0); }
    if (IN(1)) { DUP(1) {
        { pg8::Gemm g{XB, WB + WB_EVIN, MTOK, 2048, 1024, 1024}; pg8::StaticOrder S; S.init(MTOK, 2048, F.G, bid);
          pg8::EpiScaleBf16 E{Z, 2048, SSQ, 0, 16, 1.f / 1024.f, 0, 0};
          pg8::gemm_phase<pg8::EpiScaleBf16, pg8::StaticOrder, true, true>(F.lds + RING_OFF, g, S, E); }
        }
#ifdef ABL_P1
        { pg8::Gemm g{XB, WB + WB_EVIN, MTOK, 2048, 1024, 1024}; pg8::StaticOrder S; S.init(MTOK, 2048, F.G, bid);
#if ABL_P1 == 1
          pg8::EpiNull E{};
          pg8::gemm_phase<pg8::EpiNull, pg8::StaticOrder, true, true>(F.lds + RING_OFF, g, S, E);
#else
          pg8::EpiScaleBf16 E{Z, 2048, SSQ, 0, 16, 1.f / 1024.f, 0, 0, ABL_P1 == 3};
          pg8::gemm_phase<pg8::EpiScaleBf16, pg8::StaticOrder, true, true>(F.lds + RING_OFF, g, S, E);
#endif
        }
#endif
        SEAM(1);
    }

    if (IN(2)) { DUP(2) evenmix_phase(F, args); SEAM(2); }
    if (IN(3)) { pg8::Gemm g{YMIX, WB + WB_EVOUT, MTOK, 1024, 1024, 1024}; pg8::StaticOrder S; S.init(MTOK, 1024, F.G, bid);
        pg8::EpiResid E{XB, SSQ};
        pg8::gemm_phase<pg8::EpiResid, pg8::StaticOrder, true, true>(F.lds + RING_OFF, g, S, E); SEAM(3); }
#pragma unroll 1
    for (int l = 0; l < 2; ++l) {
        const int pb = l ? 14 : 4;
        if (IN(pb)) { DUP(pb) { pg8::Gemm g{XB, WB + (l ? WB_Q1 : WB_Q0), MTOK, 512, 1024, 1024}; pg8::StaticOrder S; S.init(MTOK, 512, F.G, bid);
            pg8::EpiScaleBf16 E{Z, 512, SSQ, 0, 16, 1.f / 1024.f, 0, 0};
            pg8::gemm_phase<pg8::EpiScaleBf16, pg8::StaticOrder, true, true>(F.lds + RING_OFF, g, S, E);
            { pg8::Gemm g2{(const bf16_t*)(ws + WS_MEMN), WB + WB_KV + (size_t)l * 1024 * 1024, BATCH * NMEM, 1024, 1024, 1024}; pg8::StaticOrder S2; S2.init(BATCH * NMEM, 1024, F.G, bid >= 128 ? bid - 128 : 1 << 20);
              pg8::EpiScaleBf16 E2{(bf16_t*)(ws + WS_MEMKV) + (size_t)l * 1024 * 1024, 1024, nullptr, 0, 0, 0.f, 0, 0};
              pg8::gemm_phase<pg8::EpiScaleBf16, pg8::StaticOrder, true, true>(F.lds + RING_OFF, g2, S2, E2); }
            if (bid >= 144 && rep_ == 0) { int t_ = threadIdx.x; asm volatile("" : "+v"(t_)); const int wv_ = __builtin_amdgcn_readfirstlane(t_ >> 6);
                p0_convert(args, (LAS float*)(F.lds + RING_OFF + wv_ * 16640), l == 0 ? NMATS_EARLY : NMATS_MID, l == 0 ? NMATS_MID : NMATS, (bid - 144) * NWAVES + wv_, (F.G - 144) * NWAVES, t_ & 63); }
            } SEAM(pb); }
        if (IN(pb + 1)) { DUP(pb + 1) xattn_phase(F, args, l); SEAM(pb + 1); }
        if (IN(pb + 2)) { pg8::Gemm g{Z + (size_t)MTOK * 512, WB + (l ? WB_O1 : WB_O0), MTOK, 1024, 512, 512}; pg8::StaticOrder S; S.init(MTOK, 1024, F.G, bid);
            pg8::EpiResid E{XB, SSQ};
            pg8::gemm_phase<pg8::EpiResid, pg8::StaticOrder, true, true>(F.lds + RING_OFF, g, S, E); SEAM(pb + 2); }
        if (IN(pb + 3)) { DUP(pb + 3) { pg8::Gemm g{XB, WB + (l ? WB_GU1 : WB_GU0), MTOK, 5632, 1024, 1024}; pg8::StaticOrder S; S.init(MTOK, 5632, F.G, bid);
            pg8::EpiSwiglu E{Z, SSQ};
            const int nfull = (S.nwg / F.G) * F.G, rem = S.nwg - nfull; const bool split = nfull > 0 && rem > 0 && 2 * rem <= F.G;
            if (split) S.lim = nfull;
            pg8::TailOrder T{S, nfull, rem};
            pg8::Unit tu{0, 0, 0}; const bool chain = split && T.next(0, tu);
            pg8::gemm_phase<pg8::EpiSwiglu, pg8::StaticOrder, true, true>(F.lds + RING_OFF, g, S, E, chain, tu);
            if (split) pg8::gemm_phase<pg8::EpiSwiglu, pg8::TailOrder, true, true, true, true>(F.lds + RING_OFF, g, T, E);
            } SEAM(pb + 3); }
        if (IN(pb + 4)) { pg8::Gemm g{Z, WB + (l ? WB_DN1 : WB_DN0), MTOK, 1024, 2816, 2816}; pg8::StaticOrder S; S.init(MTOK, 1024, F.G, bid);
            if (l == 1 && fuse_final) {
                pg8::EpiFinal E{XB, SSQ, args.out, args.in[25], (unsigned*)(F.ctl + CW_FIN)};
                pg8::gemm_phase<pg8::EpiFinal, pg8::StaticOrder, true, true>(F.lds + RING_OFF, g, S, E); }
            else { pg8::EpiResid E{XB, SSQ};
                pg8::gemm_phase<pg8::EpiResid, pg8::StaticOrder, true, true>(F.lds + RING_OFF, g, S, E); }
            SEAM(pb + 4); }
        if (l == 0) {
            if (IN(9)) { DUP(9) { pg8::Gemm g{XB, WB + WB_ODIN, MTOK, 2816, 1024, 1024}; pg8::StaticOrder S; S.init(MTOK, 2816, F.G, bid);
                pg8::EpiZ1 E{Z, SSQ, SSQ2, (float*)(ws + WS_GATES), args.in[18]};
                pg8::gemm_phase<pg8::EpiZ1, pg8::StaticOrder, true, true>(F.lds + RING_OFF, g, S, E); } SEAM(9); }
            if (IN(10)) { DUP(10) {
                bf16_t* QM = (bf16_t*)args.out; bf16_t* KM = QM + (size_t)MTOK * 768; bf16_t* VM = KM + (size_t)MTOK * 768; const float* ROPE = (const float*)(ws + WS_ROPE);
                { pg8::Gemm g{Z + 2048, WB + WB_UQ, MTOK, 768, 384, 2816}; pg8::StaticOrder S; S.init(MTOK, 768, F.G, bid);
                  pg8::EpiMlaQ E{QM, SSQ2, ROPE};
                  pg8::gemm_phase<pg8::EpiMlaQ, pg8::StaticOrder, true, true>(F.lds + RING_OFF, g, S, E); }
                { pg8::Gemm g{Z + 2560, WB + WB_UKV, MTOK, 1024, 256, 2816}; pg8::StaticOrder S; S.init(MTOK, 1024, F.G, bid);
                  pg8::EpiMlaKV E{KM, VM, Z, SSQ2, ROPE};
                  pg8::gemm_phase<pg8::EpiMlaKV, pg8::StaticOrder, true, true>(F.lds + RING_OFF, g, S, E); }
                mlstm_phase<0>(F, args, F.vcu, F.G);
                } SEAM(10); }
            if (IN(11)) { DUP(11) { mlstm_phase<1>(F, args, F.vcu, F.G); mla_attn_phase<0>(F, args, YMIX + 512, 1024); }
#ifdef ABL_MLA
                mla_attn_phase<ABL_MLA>(F, args, (bf16_t*)(ws + WS_EXT + 2 * MiB), 512);
#endif
                SEAM(11); }
            if (IN(13)) { pg8::Gemm g{YMIX, WB + WB_ODOUT, MTOK, 1024, 1024, 1024}; pg8::StaticOrder S; S.init(MTOK, 1024, F.G, bid);
                pg8::EpiResid E{XB, SSQ};
                pg8::gemm_phase<pg8::EpiResid, pg8::StaticOrder, true, true>(F.lds + RING_OFF, g, S, E); SEAM(13); }
        }
    }
    if (IN(19) && !fuse_final) final_norm_phase(F, args, 1.f, 0.f);
#ifdef TPROBE_LO
    xcd_barrier(bar); STAMP(20);
    if (blockIdx.x == 0 && F.tid == 0) { __builtin_amdgcn_s_waitcnt(0); args.out[0] += (float)(long long)(TS[TPROBE_HI] - TS[TPROBE_LO]) * 0.01f * TPROBE_SCALE; }
#endif
#undef IN
#undef SEAM
}
struct In {
    const float *x, *mem; const int* pos; const float *norm_mix_g, *norm_xattn_g, *mem_norm_g, *xattn_wq, *xattn_wkv, *xattn_wo, *norm_ffn_g, *ffn_gu, *ffn_down,
        *ev_w_in, *ev_conv_w, *ev_pool_w, *ev_pool_scale, *ev_w_out, *od_w_in, *od_gate_bias, *od_ml_norm_g, *od_q_norm_g, *od_kv_norm_g, *od_w_uq, *od_w_ukv, *od_w_out, *final_norm_g;
};
#ifndef FASTMASK
#define FASTMASK 0xFFFFFu
#endif
static inline bool isfast(int k) { return (FASTMASK >> k) & 1u; }
static void naive_xb(float* X, unsigned char* ws, hipStream_t st) { nv::xb_ssq<<<MTOK / 4, 256, 0, st>>>(X, (bf16_t*)(ws + WS_XB), (float*)(ws + WS_SSQ)); }
static void naive_xattn_ffn(const In& I, int l, float* X, unsigned char* ws, hipStream_t st, int k, int s0) {
    bf16_t* XB = (bf16_t*)(ws + WS_XB); bf16_t* QX = (bf16_t*)(ws + WS_Z); bf16_t* OX = (bf16_t*)(ws + WS_Z + 16 * MiB); bf16_t* HB = (bf16_t*)(ws + WS_Z);
    const bf16_t* MKV = (const bf16_t*)(ws + WS_MEMKV) + (size_t)l * 1024 * 1024;
    if (k == s0) {
        nv::rmsnorm<float, bf16_t><<<MTOK / 4, 256, 0, st>>>(X, DM, I.norm_xattn_g + l * DM, XB, DM, MTOK, DM);
        nv::gemm<0><<<dim3(512 / 64, MTOK / 64), 256, 0, st>>>(XB, DM, I.xattn_wq + (size_t)l * DM * 512, 512, MTOK, 512, DM, QX, 512, nullptr, 0); }
    if (k == s0 + 1) nv::attn<0, 128, 128><<<MTOK * 4 / 4, 256, 0, st>>>(QX, 512, MKV, 1024, MKV + 512, 1024, OX, 512, SEQ, NMEM, 4, 0, 0.08838834764831845f, nullptr, nullptr, nullptr, 0, nullptr);
    if (k == s0 + 2) nv::gemm<1><<<dim3(DM / 64, MTOK / 64), 256, 0, st>>>(OX, 512, I.xattn_wo + (size_t)l * 512 * DM, DM, MTOK, DM, 512, X, DM, X, 0);
    if (k == s0 + 3) {
        nv::rmsnorm<float, bf16_t><<<MTOK / 4, 256, 0, st>>>(X, DM, I.norm_ffn_g + l * DM, XB, DM, MTOK, DM);
        nv::gemm<2><<<dim3(FFH / 64, MTOK / 64), 256, 0, st>>>(XB, DM, I.ffn_gu + (size_t)l * DM * 2 * FFH, 2 * FFH, MTOK, FFH, DM, HB, FFH, nullptr, FFH); }
    if (k == s0 + 4) nv::gemm<1><<<dim3(DM / 64, MTOK / 64), 256, 0, st>>>(HB, FFH, I.ffn_down + (size_t)l * FFH * DM, DM, MTOK, DM, FFH, X, DM, X, 0);
}
static void naive_stage(const In& I, float* X, unsigned char* ws, hipStream_t st, int k) {
    bf16_t* XB = (bf16_t*)(ws + WS_XB); bf16_t* Z = (bf16_t*)(ws + WS_Z); bf16_t* YMIX = (bf16_t*)(ws + WS_YMIX);
    bf16_t* MEMN = (bf16_t*)(ws + WS_MEMN); bf16_t* MKV = (bf16_t*)(ws + WS_MEMKV);
    float* GATES = (float*)(ws + WS_GATES); float* FCUM = (float*)(ws + WS_FCUM);
    if (k == 1) {
        for (int l = 0; l < 2; ++l) {
            nv::rmsnorm<float, bf16_t><<<1024 / 4, 256, 0, st>>>(I.mem, DM, I.mem_norm_g + l * DM, MEMN, DM, 1024, DM);
            nv::gemm<0><<<dim3(1024 / 64, 1024 / 64), 256, 0, st>>>(MEMN, DM, I.xattn_wkv + (size_t)l * DM * 1024, 1024, 1024, 1024, DM, MKV + (size_t)l * 1024 * 1024, 1024, nullptr, 0);
        }
        nv::rmsnorm<float, bf16_t><<<MTOK / 4, 256, 0, st>>>(I.x, DM, I.norm_mix_g, XB, DM, MTOK, DM);
        nv::gemm<0><<<dim3(2048 / 64, MTOK / 64), 256, 0, st>>>(XB, DM, I.ev_w_in, 2048, MTOK, 2048, DM, Z, 2048, nullptr, 0);
    }
    if (k == 2) {
        nv::evenmix_local<<<MTOK * 512 / 256, 256, 0, st>>>(Z, I.ev_conv_w, YMIX, XB  );
        for (int gi = 0; gi < 4; ++gi)
            nv::gemm<3><<<dim3(128 / 64, MTOK / 64), 256, 0, st>>>(XB + gi * 128, 512, I.ev_pool_w + (size_t)gi * 128 * 128, 128, MTOK, 128, 128, YMIX + 512 + gi * 128, DM, I.ev_pool_scale + gi * 128, 0);
    }
    if (k == 3) nv::gemm<1><<<dim3(DM / 64, MTOK / 64), 256, 0, st>>>(YMIX, DM, I.ev_w_out, DM, MTOK, DM, DM, X, DM, I.x, 0);
    naive_xattn_ffn(I, 0, X, ws, st, k, 4);
    bf16_t* Z1 = Z;
    if (k == 9) {
        nv::rmsnorm<float, bf16_t><<<MTOK / 4, 256, 0, st>>>(X, DM, I.norm_mix_g + DM, XB, DM, MTOK, DM);
        nv::gemm<0><<<dim3(2048 / 64, MTOK / 64), 256, 0, st>>>(XB, DM, I.od_w_in, ODD_IN, MTOK, 2048, DM, Z1, 2816, nullptr, 0);
        nv::gemm<4><<<dim3(1, MTOK / 64), 256, 0, st>>>(XB, DM, I.od_w_in + 2048, ODD_IN, MTOK, 8, DM, GATES, 8, I.od_gate_bias, 0);
        nv::gemm<0><<<dim3(384 / 64, MTOK / 64), 256, 0, st>>>(XB, DM, I.od_w_in + 2056, ODD_IN, MTOK, 384, DM, Z1 + 2048, 2816, nullptr, 0);
        nv::gemm<0><<<dim3(256 / 64, MTOK / 64), 256, 0, st>>>(XB, DM, I.od_w_in + 2440, ODD_IN, MTOK, 256, DM, Z1 + 2560, 2816, nullptr, 0);
        nv::gemm<0><<<dim3(1, MTOK / 64), 256, 0, st>>>(XB, DM, I.od_w_in + 2696, ODD_IN, MTOK, 32, DM, Z1 + 2432, 2816, nullptr, 0);
    }
    if (k == 10) {
        nv::fcum_kernel<<<1, 64, 0, st>>>(GATES, FCUM);
        nv::attn<1, 128, 128><<<MTOK * 4 / 4, 256, 0, st>>>(Z1, 2816, Z1 + 512, 2816, Z1 + 1024, 2816, YMIX, DM, SEQ, SEQ, 4, 1, 0.08838834764831845f, FCUM, GATES, Z1 + 1536, 2816, I.od_ml_norm_g);
    }
    bf16_t* QM = (bf16_t*)(ws + WS_XB); bf16_t* KM = QM + (size_t)MTOK * 768; bf16_t* VM = KM + (size_t)MTOK * 768;
    if (k == 11) {
        bf16_t* S1 = XB; bf16_t* S2 = XB + (size_t)MTOK * 384; bf16_t* KRAW = MEMN; bf16_t* QRAW = Z; bf16_t* KVRAW = Z + (size_t)MTOK * 768;
        nv::rmsnorm<bf16_t, bf16_t><<<MTOK / 4, 256, 0, st>>>(Z1 + 2048, 2816, I.od_q_norm_g, S1, 384, MTOK, 384);
        nv::rmsnorm<bf16_t, bf16_t><<<MTOK / 4, 256, 0, st>>>(Z1 + 2560, 2816, I.od_kv_norm_g, S2, 256, MTOK, 256);
        nv::copy_cols<<<MTOK * 32 / 256, 256, 0, st>>>(Z1 + 2432, 2816, KRAW, 32, MTOK, 32);
        nv::gemm<0><<<dim3(768 / 64, MTOK / 64), 256, 0, st>>>(S1, 384, I.od_w_uq, 768, MTOK, 768, 384, QRAW, 768, nullptr, 0);
        nv::gemm<0><<<dim3(1024 / 64, MTOK / 64), 256, 0, st>>>(S2, 256, I.od_w_ukv, 1024, MTOK, 1024, 256, KVRAW, 1024, nullptr, 0);
        nv::mla_pack<<<MTOK * 768 / 256, 256, 0, st>>>(QRAW, KVRAW, KRAW, 32, I.pos, QM, KM, VM);
    }
    if (k == 12) nv::attn<0, 96, 64><<<MTOK * 8 / 4, 256, 0, st>>>(QM, 768, KM, 768, VM, 512, YMIX + 512, DM, SEQ, SEQ, 8, 1, 0.10206207261596575f, nullptr, nullptr, nullptr, 0, nullptr);
    if (k == 13) nv::gemm<1><<<dim3(DM / 64, MTOK / 64), 256, 0, st>>>(YMIX, DM, I.od_w_out, DM, MTOK, DM, DM, X, DM, X, 0);
    naive_xattn_ffn(I, 1, X, ws, st, k, 14);
    if (k == 19) nv::rmsnorm<float, float><<<MTOK / 4, 256, 0, st>>>(X, DM, I.final_norm_g, X, DM, MTOK, DM);
}
static void fill_mats(Args& a, const In& I, unsigned char* ws) {
    bf16_t* WB = (bf16_t*)(ws + WS_WB); int n = 0;
    auto add = [&](const float* W, const float* gain, size_t dst, int ldw, int K, int Ndst, int map) { a.mats[n].W = W; a.mats[n].gain = gain; a.mats[n].dst = WB + dst; a.mats[n].ldw = ldw; a.mats[n].K = K; a.mats[n].Ndst = Ndst; a.mats[n].map = map; ++n; };
    add(I.ev_w_in, I.norm_mix_g, WB_EVIN, 2048, 1024, 2048, 0);
    add(I.ev_w_out, nullptr, WB_EVOUT, 1024, 1024, 1024, 0);
    for (int gi = 0; gi < 4; ++gi) add(I.ev_pool_w + (size_t)gi * 128 * 128, nullptr, WB_POOL + (size_t)gi * 128 * 128, 128, 128, 128, 0);
    add(I.xattn_wq, I.norm_xattn_g, WB_Q0, 512, 1024, 512, 0);
    add(I.xattn_wo, nullptr, WB_O0, 1024, 512, 1024, 0);
    add(I.xattn_wkv, I.mem_norm_g, WB_KV, 1024, 1024, 1024, 0);
    add(I.ffn_gu, I.norm_ffn_g, WB_GU0, 5632, 1024, 5632, 1);
    add(I.ffn_down, nullptr, WB_DN0, 1024, 2816, 1024, 0);
    add(I.xattn_wq + (size_t)1024 * 512, I.norm_xattn_g + 1024, WB_Q1, 512, 1024, 512, 0);
    add(I.xattn_wo + (size_t)512 * 1024, nullptr, WB_O1, 1024, 512, 1024, 0);
    add(I.xattn_wkv + (size_t)1024 * 1024, I.mem_norm_g + 1024, WB_KV + (size_t)1024 * 1024, 1024, 1024, 1024, 0);
    add(I.od_w_in, I.norm_mix_g + 1024, WB_ODIN, ODD_IN, 1024, 2816, 2);
    add(I.od_w_uq, I.od_q_norm_g, WB_UQ, 768, 384, 768, 0);
    add(I.od_w_ukv, I.od_kv_norm_g, WB_UKV, 1024, 256, 1024, 0);
    add(I.od_w_out, nullptr, WB_ODOUT, 1024, 1024, 1024, 0);
    add(I.ffn_gu + (size_t)1024 * 5632, I.norm_ffn_g + 1024, WB_GU1, 5632, 1024, 5632, 1);
    add(I.ffn_down + (size_t)2816 * 1024, nullptr, WB_DN1, 1024, 2816, 1024, 0);
    if (n != NMATS) fprintf(stderr, "fill_mats: %d matrices, expected %d\n", n, NMATS);
}
extern "C" void kernel_launch(void* const* d_in, const int* in_sizes, int n_in, void* d_out, int out_size, void* d_ws, size_t ws_size, hipStream_t stream) {
    static int grid = 0;
    if (n_in != 26 || out_size != MTOK * DM || ws_size < WS_END) { fprintf(stderr, "kernel_launch: unexpected shapes n_in %d out %d ws %zu\n", n_in, out_size, ws_size); return; }
    In I;
    I.x = (const float*)d_in[0]; I.mem = (const float*)d_in[1]; I.pos = (const int*)d_in[2]; I.norm_mix_g = (const float*)d_in[3]; I.norm_xattn_g = (const float*)d_in[4];
    I.mem_norm_g = (const float*)d_in[5]; I.xattn_wq = (const float*)d_in[6]; I.xattn_wkv = (const float*)d_in[7]; I.xattn_wo = (const float*)d_in[8]; I.norm_ffn_g = (const float*)d_in[9];
    I.ffn_gu = (const float*)d_in[10]; I.ffn_down = (const float*)d_in[11]; I.ev_w_in = (const float*)d_in[12]; I.ev_conv_w = (const float*)d_in[13]; I.ev_pool_w = (const float*)d_in[14];
    I.ev_pool_scale = (const float*)d_in[15]; I.ev_w_out = (const float*)d_in[16]; I.od_w_in = (const float*)d_in[17]; I.od_gate_bias = (const float*)d_in[18]; I.od_ml_norm_g = (const float*)d_in[19];
    I.od_q_norm_g = (const float*)d_in[20]; I.od_kv_norm_g = (const float*)d_in[21]; I.od_w_uq = (const float*)d_in[22]; I.od_w_ukv = (const float*)d_in[23]; I.od_w_out = (const float*)d_in[24];
    I.final_norm_g = (const float*)d_in[25];
    if (grid == 0) {
        int dev = 0, cus = 0, per_cu = 0;
        if (hipGetDevice(&dev) != hipSuccess || hipDeviceGetAttribute(&cus, hipDeviceAttributeMultiprocessorCount, dev) != hipSuccess) { grid = -1; return; }
        if (hipFuncSetAttribute((const void*)mega, hipFuncAttributeMaxDynamicSharedMemorySize, LDS_BYTES) != hipSuccess) { fprintf(stderr, "hipFuncSetAttribute failed\n"); grid = -1; return; }
        if (hipOccupancyMaxActiveBlocksPerMultiprocessor(&per_cu, (const void*)mega, NWAVES * 64, LDS_BYTES) != hipSuccess || per_cu < 1) { fprintf(stderr, "occupancy query: %d\n", per_cu); (void)hipGetLastError(); per_cu = 1; }
        grid = cus;
    }
    if (grid < 0) return;
    (void)hipMemsetAsync((char*)d_ws + WS_CTL + CW_BAR * 4, 0, (2 * XCD_BAR_WORDS + 64 * 64) * 4, stream);
    Args a{};
    for (int i = 0; i < 26; ++i) a.in[i] = (const float*)d_in[i];
    a.out = (float*)d_out; a.ws = (unsigned char*)d_ws; fill_mats(a, I, (unsigned char*)d_ws);
    int li = 0;
    for (int k = 0; k < NPHASE; ) {
        if (isfast(k)) { int k2 = k; while (k2 < NPHASE && isfast(k2)) ++k2;
            a.ph_lo = k; a.ph_hi = k2; a.li = li++;
            hipLaunchKernelGGL(mega, dim3(grid), dim3(NWAVES * 64), LDS_BYTES, stream, a); k = k2; }
        else { naive_stage(I, (float*)d_out, (unsigned char*)d_ws, stream, k);
            if (k == 3 || k == 6 || k == 8 || k == 13 || k == 16 || k == 18) naive_xb((float*)d_out, (unsigned char*)d_ws, stream);
            ++k; }
    }
}
```
